# Optimizing an MI355X kernel written in HIP

```python
import jax, jax.numpy as jnp
from jax import lax
import numpy as np

D_MODEL = 1024
BATCH = 1
SEQ = 16384
DEPTH = 1

GRID_W = 64
D_CONV = 512
CONV_WIDTH = 31
N_HEADS = 8
HEAD_DIM = 64
D_ATTN = N_HEADS * HEAD_DIM
WIN_H_MAX = 8
WIN_W = 16
N_EXPERTS = 64
TOP_K = 8
N_GROUPS = 8
TOPK_GROUPS = 4
D_EXPERT = 256
D_SHARED = 256
ROUTE_SCALE = 2.5
DISPATCH_BLOCK = 128
EPS = 1e-6
SPLITS = (D_CONV, 2 * D_CONV, 2 * D_CONV + D_ATTN, 2 * D_CONV + 2 * D_ATTN,
          2 * D_CONV + 3 * D_ATTN, 2 * D_CONV + 3 * D_ATTN + D_MODEL)
D_IN = 2 * D_CONV + 3 * D_ATTN + 2 * D_MODEL

kernel_name = 'hybrid_conformer_natten_moe_block'


def rms_norm(x, g):
    xf = x.astype(jnp.float32)
    y = xf * lax.rsqrt(jnp.mean(xf * xf, axis=-1, keepdims=True) + EPS)
    return (y * g.astype(jnp.float32)).astype(x.dtype)


def layer_norm(x, g, b):
    xf = x.astype(jnp.float32)
    mu = jnp.mean(xf, axis=-1, keepdims=True)
    var = jnp.mean(jnp.square(xf - mu), axis=-1, keepdims=True)
    y = (xf - mu) * lax.rsqrt(var + EPS)
    return (y * g.astype(jnp.float32) + b.astype(jnp.float32)).astype(x.dtype)


def conformer_conv(a, gate, w_dw, b_dw, ln_g, ln_b, w_pw):
    u = a * jax.nn.sigmoid(gate)
    pad = CONV_WIDTH // 2
    u = lax.conv_general_dilated(
        u, w_dw.astype(u.dtype), window_strides=(1,), padding=[(pad, pad)],
        dimension_numbers=('NWC', 'WIO', 'NWC'), feature_group_count=D_CONV) + b_dw
    u = jax.nn.silu(layer_norm(u, ln_g, ln_b))
    return u @ w_pw


def neighbourhood_attention(q, k, v, rpb):
    b, s = q.shape[0], q.shape[1]
    rows = s // GRID_W
    win_h = min(WIN_H_MAX, rows)
    grid = (b, rows, GRID_W, N_HEADS, HEAD_DIM)
    q, k, v = q.reshape(grid), k.reshape(grid), v.reshape(grid)
    cols = jnp.arange(GRID_W)
    col_start = jnp.clip(cols - WIN_W // 2, 0, GRID_W - WIN_W)
    col_idx = col_start[:, None] + jnp.arange(WIN_W)
    col_bias_idx = col_idx - cols[:, None] + (WIN_W - 1)
    scale = HEAD_DIM ** -0.5

    def one_row(r):
        rs = jnp.clip(r - win_h // 2, 0, rows - win_h)
        q_r = lax.dynamic_index_in_dim(q, r, axis=1, keepdims=False)
        k_slab = lax.dynamic_slice_in_dim(k, rs, win_h, axis=1)
        v_slab = lax.dynamic_slice_in_dim(v, rs, win_h, axis=1)
        k_win = k_slab[:, :, col_idx]
        v_win = v_slab[:, :, col_idx]
        row_bias_idx = rs + jnp.arange(win_h) - r + (WIN_H_MAX - 1)
        bias = rpb[:, row_bias_idx[None, :, None], col_bias_idx[:, None, :]]
        sc = jnp.einsum('bqhd,biqjhd->bhqij', q_r, k_win).astype(jnp.float32) * scale
        sc = sc + bias.astype(jnp.float32)[None]
        p = jax.nn.softmax(sc.reshape(b, N_HEADS, GRID_W, win_h * WIN_W), axis=-1)
        p = p.reshape(b, N_HEADS, GRID_W, win_h, WIN_W).astype(v.dtype)
        return jnp.einsum('bhqij,biqjhd->bqhd', p, v_win)

    out = lax.map(one_row, jnp.arange(rows))
    return out.transpose(1, 0, 2, 3, 4).reshape(b, s, D_ATTN)


def moe_ffn(h, w_router, router_bias, w_gate, w_up, w_down, w_sh_gate, w_sh_up, w_sh_down):
    b, s, d = h.shape
    n = b * s
    hf = h.reshape(n, d)
    scores = jax.nn.sigmoid((hf @ w_router).astype(jnp.float32))
    biased = scores + router_bias.astype(jnp.float32)
    per_group = N_EXPERTS // N_GROUPS
    grp_score = lax.top_k(biased.reshape(n, N_GROUPS, per_group), 2)[0].sum(-1)
    _, grp_idx = lax.top_k(grp_score, TOPK_GROUPS)
    grp_mask = jnp.any(grp_idx[..., None] == jnp.arange(N_GROUPS), axis=1)
    masked = jnp.where(jnp.repeat(grp_mask, per_group, axis=1), biased, -jnp.inf)
    _, idx = lax.top_k(masked, TOP_K)
    wts = jnp.take_along_axis(scores, idx, axis=1)
    wts = wts / jnp.sum(wts, axis=-1, keepdims=True) * ROUTE_SCALE
    nk = n * TOP_K
    n_blocks = (nk + N_EXPERTS * (DISPATCH_BLOCK - 1) + DISPATCH_BLOCK - 1) // DISPATCH_BLOCK
    flat_e = idx.reshape(nk)
    order = jnp.argsort(flat_e)
    sorted_e = flat_e[order]
    counts = jnp.bincount(flat_e, length=N_EXPERTS)
    padded = (counts + DISPATCH_BLOCK - 1) // DISPATCH_BLOCK * DISPATCH_BLOCK
    start = jnp.cumsum(counts) - counts
    pad_end = jnp.cumsum(padded)
    pad_start = pad_end - padded
    dest = pad_start[sorted_e] + jnp.arange(nk) - start[sorted_e]
    n_slots = n_blocks * DISPATCH_BLOCK
    slot_tok = jnp.full((n_slots,), n, jnp.int32).at[dest].set((order // TOP_K).astype(jnp.int32))
    slot_w = jnp.zeros((n_slots,), jnp.float32).at[dest].set(wts.reshape(nk)[order])
    block_expert = jnp.clip(jnp.searchsorted(pad_end, jnp.arange(n_blocks) * DISPATCH_BLOCK, side='right'),
                            0, N_EXPERTS - 1)
    h_pad = jnp.concatenate([hf, jnp.zeros((1, d), hf.dtype)], axis=0)

    def expert_block(args):
        tok, w, e = args
        xb = h_pad[tok]
        y = (jax.nn.silu(xb @ w_gate[e]) * (xb @ w_up[e])) @ w_down[e]
        return y * w[:, None].astype(y.dtype)

    yb = lax.map(expert_block, (slot_tok.reshape(n_blocks, DISPATCH_BLOCK),
                                slot_w.reshape(n_blocks, DISPATCH_BLOCK), block_expert))
    routed = jax.ops.segment_sum(yb.reshape(n_slots, d), slot_tok, num_segments=n + 1)[:n]
    shared = (jax.nn.silu(hf @ w_sh_gate) * (hf @ w_sh_up)) @ w_sh_down
    return (routed + shared).reshape(b, s, d)


def setup_inputs(seed: int = 0) -> dict:
    key = jax.random.key(seed)
    ks = jax.random.split(key, 24)
    L = DEPTH
    f32 = jnp.float32

    def nrm(k, shape, scale):
        return jax.random.normal(k, shape, f32) * scale

    return {
        'x': nrm(ks[0], (BATCH, SEQ, D_MODEL), 1.0),
        'norm_mix_g': 1.0 + nrm(ks[1], (L, D_MODEL), 0.02),
        'w_in': nrm(ks[2], (L, D_MODEL, D_IN), D_MODEL ** -0.5),
        'q_norm_g': 1.0 + nrm(ks[3], (L, HEAD_DIM), 0.02),
        'k_norm_g': 1.0 + nrm(ks[4], (L, HEAD_DIM), 0.02),
        'rpb': nrm(ks[5], (L, N_HEADS, 2 * WIN_H_MAX - 1, 2 * WIN_W - 1), 0.5),
        'conv_dw_w': nrm(ks[6], (L, CONV_WIDTH, 1, D_CONV), CONV_WIDTH ** -0.5),
        'conv_dw_b': nrm(ks[7], (L, D_CONV), 0.02),
        'conv_ln_g': 1.0 + nrm(ks[8], (L, D_CONV), 0.02),
        'conv_ln_b': nrm(ks[9], (L, D_CONV), 0.02),
        'w_conv_out': nrm(ks[10], (L, D_CONV, D_MODEL), D_CONV ** -0.5),
        'w_attn_out': nrm(ks[11], (L, D_ATTN, D_MODEL), D_ATTN ** -0.5),
        'w_o': nrm(ks[12], (L, D_MODEL, D_MODEL), D_MODEL ** -0.5),
        'norm_ffn_g': 1.0 + nrm(ks[13], (L, D_MODEL), 0.02),
        'w_router': nrm(ks[14], (L, D_MODEL, N_EXPERTS), D_MODEL ** -0.5),
        'router_bias': nrm(ks[15], (L, N_EXPERTS), 0.01),
        'w_exp_gate': nrm(ks[16], (L, N_EXPERTS, D_MODEL, D_EXPERT), D_MODEL ** -0.5),
        'w_exp_up': nrm(ks[17], (L, N_EXPERTS, D_MODEL, D_EXPERT), D_MODEL ** -0.5),
        'w_exp_down': nrm(ks[18], (L, N_EXPERTS, D_EXPERT, D_MODEL), D_EXPERT ** -0.5),
        'w_sh_gate': nrm(ks[19], (L, D_MODEL, D_SHARED), D_MODEL ** -0.5),
        'w_sh_up': nrm(ks[20], (L, D_MODEL, D_SHARED), D_MODEL ** -0.5),
        'w_sh_down': nrm(ks[21], (L, D_SHARED, D_MODEL), D_SHARED ** -0.5),
    }


def reference(x, norm_mix_g, w_in, q_norm_g, k_norm_g, rpb, conv_dw_w, conv_dw_b, conv_ln_g,
              conv_ln_b, w_conv_out, w_attn_out, w_o, norm_ffn_g, w_router, router_bias,
              w_exp_gate, w_exp_up, w_exp_down, w_sh_gate, w_sh_up, w_sh_down):
    b, s, _ = x.shape
    for l in range(DEPTH):
        h = rms_norm(x, norm_mix_g[l])
        proj = h @ w_in[l]
        a, glu_gate, q, k, v, g_a, g_b = jnp.split(proj, SPLITS, axis=-1)
        y_conv = conformer_conv(a, glu_gate, conv_dw_w[l], conv_dw_b[l], conv_ln_g[l],
                                conv_ln_b[l], w_conv_out[l])
        heads = (b, s, N_HEADS, HEAD_DIM)
        q = rms_norm(q.reshape(heads), q_norm_g[l])
        k = rms_norm(k.reshape(heads), k_norm_g[l])
        v = v.reshape(heads)
        y_attn = neighbourhood_attention(q, k, v, rpb[l]) @ w_attn_out[l]
        merged = jax.nn.sigmoid(g_a) * y_conv + jax.nn.sigmoid(g_b) * y_attn
        x = x + merged @ w_o[l]
        x = x + moe_ffn(rms_norm(x, norm_ffn_g[l]), w_router[l], router_bias[l], w_exp_gate[l],
                        w_exp_up[l], w_exp_down[l], w_sh_gate[l], w_sh_up[l], w_sh_down[l])
    return x
```

```cpp
#include <hip/hip_runtime.h>
#include <stdint.h>

#ifndef PROBE
#define PROBE 0
#endif
#define REPS(k) ((PROBE == (k)) ? 2 : 1)
#define LAS __attribute__((address_space(3)))
typedef unsigned short bf16;
typedef short bf16x8 __attribute__((ext_vector_type(8)));
typedef float f32x4 __attribute__((ext_vector_type(4)));
typedef unsigned u32x2 __attribute__((ext_vector_type(2)));
typedef unsigned u32x4 __attribute__((ext_vector_type(4)));

constexpr int S = 16384, D = 1024, DIN = 4608, DC = 512, NH = 8, HD = 64, GW = 64, ROWS = 256;
constexpr int NE = 64, TOPK = 8, NG = 8, TOPG = 4, DE = 256;
constexpr float EPS = 1e-6f, ROUTE_SCALE = 2.5f;
constexpr int MAXT = 576;
constexpr int MAXSLOT = MAXT * 256;
constexpr int NTHR = 512, NWAVES = 8;

constexpr size_t MiB = 1u << 20;
constexpr size_t WS_CTL = 0;
constexpr size_t CTL_BYTES = 65536;
constexpr size_t WS_WIN = 1 * MiB;
constexpr size_t WS_WCAT = 10 * MiB;
constexpr size_t WS_WO = 12 * MiB;
constexpr size_t WS_WRH = 14 * MiB;
constexpr size_t WS_WRL = 14 * MiB + 256 * 1024;
constexpr size_t WS_H = 16 * MiB;
constexpr size_t WS_U2 = 16 * MiB;
constexpr size_t WS_AO = 16 * MiB;
constexpr size_t WS_K = 48 * MiB;
constexpr size_t WS_VT = 64 * MiB;
constexpr size_t WS_MRG = 48 * MiB;
constexpr size_t WS_WGU = 80 * MiB;
constexpr size_t WS_SGA = 146 * MiB;
constexpr size_t WS_SGB = 178 * MiB;
constexpr size_t WS_Q = 210 * MiB;
constexpr size_t WS_HMID = 146 * MiB;
constexpr size_t WS_TIDX = 226 * MiB;
constexpr size_t WS_TW = 227 * MiB;
constexpr size_t WS_STOK = 228 * MiB;
constexpr size_t WS_SW = 229 * MiB;
constexpr size_t WS_TSLOT = 230 * MiB;
constexpr size_t WS_SRS = 231 * MiB;
constexpr size_t WS_CNTB = 232 * MiB;
constexpr size_t WS_WD = 236 * MiB;
constexpr size_t WS_U = 269 * MiB;
constexpr size_t WS_Y = 1 * MiB;
constexpr size_t WS_YSH = 269 * MiB;
constexpr size_t WS_YSC = 233 * MiB;
constexpr size_t WS_END = 285 * MiB;

constexpr int C_XN = 8000, C_XL = 8192;
constexpr int C_CUR2 = 3000; constexpr int C_CNT = 0, C_CUR = 64, C_PADSTART = 128, C_NT = 200, C_TEXP = 256, CW_BAR = 4096;
constexpr int LDS_BYTES = 163840, LDS_CTL_OFF = 159744, WSCR_BYTES = 17408;
constexpr int AUX_OFF = 131072;

struct Params {
    const float *x, *norm_mix_g, *w_in, *q_norm_g, *k_norm_g, *rpb, *conv_w, *conv_b, *ln_g, *ln_b, *w_conv_out, *w_attn_out, *w_o,
        *norm_ffn_g, *w_router, *router_bias, *w_eg, *w_eu, *w_ed, *w_sg, *w_su, *w_sd;
    float* out; unsigned char* ws;
};

__device__ __forceinline__ unsigned f2bf(float f) { unsigned u = __float_as_uint(f); return (u + 0x7fffu + ((u >> 16) & 1u)) >> 16; }
__device__ __forceinline__ float bf2f(unsigned h) { return __uint_as_float(h << 16); }
typedef __bf16 bf16x2_t __attribute__((ext_vector_type(2)));
typedef float f32x2_t __attribute__((ext_vector_type(2)));
__device__ __forceinline__ unsigned pk2(float lo, float hi) { f32x2_t f = {lo, hi}; bf16x2_t b = __builtin_convertvector(f, bf16x2_t); return __builtin_bit_cast(unsigned, b); }
__device__ __forceinline__ float sigmoidf_(float v) { return 1.f / (1.f + __expf(-v)); }
__device__ __forceinline__ int ldc(const int* p) { return __hip_atomic_load(p, __ATOMIC_RELAXED, __HIP_MEMORY_SCOPE_AGENT); }
__device__ __forceinline__ float wave_sum(float v) {
#define WS_DPP(x, ctrl) __uint_as_float((unsigned)__builtin_amdgcn_update_dpp(0, (int)__float_as_uint(x), ctrl, 0xf, 0xf, true))
    v += WS_DPP(v, 0xB1); v += WS_DPP(v, 0x4E); v += WS_DPP(v, 0x141); v += WS_DPP(v, 0x140);
#undef WS_DPP
    const int iv = (int)__float_as_uint(v);
    const float r0 = __uint_as_float((unsigned)__builtin_amdgcn_readlane(iv, 0)), r1 = __uint_as_float((unsigned)__builtin_amdgcn_readlane(iv, 16)),
                r2 = __uint_as_float((unsigned)__builtin_amdgcn_readlane(iv, 32)), r3 = __uint_as_float((unsigned)__builtin_amdgcn_readlane(iv, 48));
    return (r0 + r1) + (r2 + r3);
}

#define XB_TMO      128
#define XB_XCNT(j)  (256  + 64 * (j))
#define XB_XSUB(j)  (1280 + 64 * (j))
#define XB_XGEN(j)  (2304 + 64 * (j))
#define XB_TOP      3328
#define XB_TOPGEN   3392
#define XCD_BAR_WORDS 3456
#define XB_SPIN_CAP (1u << 18)
__device__ __forceinline__ unsigned xb_ld(unsigned* p)              { return __hip_atomic_load(p, __ATOMIC_RELAXED, __HIP_MEMORY_SCOPE_AGENT); }
__device__ __forceinline__ unsigned xb_add(unsigned* p, unsigned v) { return __hip_atomic_fetch_add(p, v, __ATOMIC_RELAXED, __HIP_MEMORY_SCOPE_AGENT); }
__device__ __forceinline__ unsigned xb_xcc_id() { return (unsigned)__builtin_amdgcn_s_getreg((3 << 11) | 20) & 0xFu; }
#define XB_SPIN(cond, bar) do { unsigned _sp = 0; while (cond) { __builtin_amdgcn_s_sleep(1); \
    if ((++_sp & 255u) == 0u) { if (xb_ld(&(bar)[XB_TMO])) break; if (_sp > XB_SPIN_CAP) { atomicAdd(&(bar)[XB_TMO], 1u); break; } } } } while (0)
struct XcdBarrier { unsigned* bar; unsigned x; volatile LAS unsigned* st; };
__device__ __forceinline__ XcdBarrier xcd_barrier_post(unsigned* bar, volatile LAS unsigned* st, bool leader) {
    XcdBarrier b; b.bar = bar; b.x = xb_xcc_id(); b.st = st;
    if (leader) (void)xb_add(&bar[XB_XCNT(b.x)], 1u);
    return b;
}
__device__ __forceinline__ void xcd_barrier_complete(unsigned* bar, unsigned x, unsigned& nloc, unsigned& nx) {
    const unsigned G = gridDim.x * gridDim.y * gridDim.z;
    unsigned sum, cnt, mine, sp = 0u;
    for (;;) {
        sum = 0u; cnt = 0u; mine = 0u;
#pragma unroll
        for (unsigned j = 0; j < 16; ++j) { const unsigned c = xb_ld(&bar[XB_XCNT(j)]); sum += c; cnt += (c > 0u) ? 1u : 0u; mine = (j == x) ? c : mine; }
        if (sum == G) break;
        __builtin_amdgcn_s_sleep(1);
        if ((++sp & 255u) == 0u) { if (xb_ld(&bar[XB_TMO])) break; if (sp > XB_SPIN_CAP) { atomicAdd(&bar[XB_TMO], 1u); break; } }
    }
    nloc = mine > 0u ? mine : 1u; nx = cnt > 0u ? cnt : 1u;
}
__device__ __forceinline__ void xcd_barrier1(const XcdBarrier& b, bool leader) {
    asm volatile("s_waitcnt vmcnt(0)" ::: "memory");
    __syncthreads();
    if (leader) {
        unsigned* bar = b.bar;
        __builtin_amdgcn_s_waitcnt(0);
        unsigned nloc = b.st[0], nx = b.st[1];
        if (nloc == 0u) { xcd_barrier_complete(bar, b.x, nloc, nx); b.st[0] = nloc; b.st[1] = nx; }
        const unsigned old = xb_add(&bar[XB_XSUB(b.x)], 1u);
        const unsigned gen = old / nloc;
        if (old + 1u == (gen + 1u) * nloc) {
            __builtin_amdgcn_fence(__ATOMIC_RELEASE, "agent");
            asm volatile("s_waitcnt vmcnt(0)" ::: "memory");
            const unsigned og = xb_add(&bar[XB_TOP], 1u);
            const unsigned tg = og / nx;
            if (og + 1u == (tg + 1u) * nx) xb_add(&bar[XB_TOPGEN], 1u);
            else XB_SPIN(xb_ld(&bar[XB_TOPGEN]) == tg, bar);
            __builtin_amdgcn_fence(__ATOMIC_ACQUIRE, "agent");
            xb_add(&bar[XB_XGEN(b.x)], 1u);
            asm volatile("s_waitcnt vmcnt(0)" ::: "memory");
        } else {
            XB_SPIN(xb_ld(&bar[XB_XGEN(b.x)]) == gen, bar);
            __builtin_amdgcn_fence(__ATOMIC_ACQUIRE, "agent");
            asm volatile("s_waitcnt vmcnt(0)" ::: "memory");
        }
    }
    __syncthreads();
}

__device__ __forceinline__ void xcd_barrier_(const XcdBarrier& b, bool leader) { xcd_barrier1(b, leader); if (PROBE == 99) xcd_barrier1(b, leader); }
__device__ __forceinline__ int owid(int WID) { int w = WID; asm volatile("" : "+s"(w)); return w; }
__device__ __forceinline__ int otid(int WID) { int l; asm volatile("v_mbcnt_lo_u32_b32 %0, -1, 0\n\tv_mbcnt_hi_u32_b32 %0, -1, %0" : "=v"(l)); return owid(WID) * 64 + l; }
struct MapId { int off; __device__ __forceinline__ int operator()(int n) const { return off + n; } };
struct MapIn {
    __device__ __forceinline__ int operator()(int n) const {
        if (n < 512) return 256 * (n >> 7) + (n & 127);
        if (n < 1024) { const int c = n - 512; return 256 * (c >> 7) + 128 + (c & 127); }
        if (n < 2048) { const int base = n < 1536 ? 1024 : 1536, c = n - base, h = c >> 6, d = c & 63; return base + 256 * (h >> 2) + (d >> 5) * 128 + 32 * (h & 3) + (d & 31); }
        return n; } };
struct MapDown { __device__ __forceinline__ int operator()(int c) const { const int o = c & 255; return (c & ~255) + 128 * ((o >> 3) & 1) + 32 * (o >> 6) + 8 * ((o >> 4) & 3) + (o & 7); } };
struct MapGU { int up; __device__ __forceinline__ int operator()(int c) const { return 256 * (c >> 7) + 128 * up + (c & 127); } };
template <bool LO, class Map> __device__ __forceinline__ void transpose_item(const float* W, int K, int N, bf16* WT, int ldo, int kofs, const Map& map, const float* gk, float* scr, int item, int lane) {
    const int nblk = N / 64, kb = item / nblk, nb = item % nblk, k0 = 64 * kb, n0 = 64 * nb;
    const int kr = lane >> 4, n4 = (lane & 15) * 4;
#pragma unroll
    for (int i = 0; i < 16; ++i) { const int kk = kr + 4 * i; f32x4 v = __builtin_nontemporal_load((const f32x4*)(W + (size_t)(k0 + kk) * N + n0 + n4)); if (gk) v = v * gk[k0 + kk];
        *(f32x4*)(scr + kk * 64 + (n4 ^ (4 * ((kk >> 3) & 7)))) = v; }
    asm volatile("s_waitcnt lgkmcnt(0)" ::: "memory");
    const int c = lane & 7;
#pragma unroll
    for (int j = 0; j < 8; ++j) { const int n = (lane >> 3) + 8 * j; const float* sp = scr + (8 * c) * 64 + (n ^ (4 * c)); float f[8];
#pragma unroll
        for (int i = 0; i < 8; ++i) { f[i] = sp[i * 64]; if (LO) f[i] -= bf2f(pk2(f[i], 0.f) & 0xffffu); }
        u32x4 o; o.x = pk2(f[0], f[1]); o.y = pk2(f[2], f[3]); o.z = pk2(f[4], f[5]); o.w = pk2(f[6], f[7]);
        *(u32x4*)(WT + (size_t)map(n0 + n) * ldo + kofs + k0 + 8 * c) = o; }
    asm volatile("s_waitcnt lgkmcnt(0)" ::: "memory");
}
__device__ __forceinline__ void rmsnorm_row(const float* xrow, const float* g, bf16* orow, int lane) {
    const f32x4* xr = (const f32x4*)xrow + lane; f32x4 v[4]; float s = 0.f;
#pragma unroll
    for (int j = 0; j < 4; ++j) { v[j] = __builtin_nontemporal_load(xr + 64 * j); s += (v[j].x * v[j].x + v[j].y * v[j].y) + (v[j].z * v[j].z + v[j].w * v[j].w); }
    const float rs = rsqrtf(wave_sum(s) * (1.f / D) + EPS);
    u32x2* o = (u32x2*)orow + lane;
#pragma unroll
    for (int j = 0; j < 4; ++j) { const f32x4 gg = ((const f32x4*)g)[lane + 64 * j];
        u32x2 w2; w2.x = pk2(v[j].x * rs * gg.x, v[j].y * rs * gg.y); w2.y = pk2(v[j].z * rs * gg.z, v[j].w * rs * gg.w); o[64 * j] = w2; }
}

template <class P> __device__ __forceinline__ void wave_gemm_acc(const P& p, int m0, int n0, int K, f32x4 (&acc)[4][4], int lane) {
    const int g = lane >> 4, li = lane & 15;
    const bf16* ap[4]; const bf16* bp[4];
#pragma unroll
    for (int i = 0; i < 4; ++i) { ap[i] = p.arow(m0 + 16 * i + li) + 8 * g; bp[i] = p.brow(n0 + 16 * i + li) + 8 * g; }
    for (int k0 = 0; k0 < K; k0 += 32) {
        bf16x8 a[4], b[4];
#pragma unroll
        for (int i = 0; i < 4; ++i) { a[i] = *(const bf16x8*)(ap[i] + k0); b[i] = *(const bf16x8*)(bp[i] + k0); }
#pragma unroll
        for (int i = 0; i < 4; ++i)
#pragma unroll
            for (int j = 0; j < 4; ++j) acc[i][j] = __builtin_amdgcn_mfma_f32_16x16x32_bf16(b[j], a[i], acc[i][j], 0, 0, 0);
    }
}
__device__ __forceinline__ void zero_acc(f32x4 (&acc)[4][4]) {
#pragma unroll
    for (int i = 0; i < 4; ++i)
#pragma unroll
        for (int j = 0; j < 4; ++j) acc[i][j] = (f32x4){0.f, 0.f, 0.f, 0.f};
}
struct RowMat { const bf16* a; int lda; const bf16* b; int ldb;
    __device__ __forceinline__ const bf16* arow(int m) const { return a + (size_t)m * lda; }
    __device__ __forceinline__ const bf16* brow(int n) const { return b + (size_t)n * ldb; } };

struct ProjMat { const bf16* h; const bf16* wt;
    __device__ __forceinline__ const bf16* arow(int m) const { return h + (size_t)m * D; }
    __device__ __forceinline__ const bf16* brow(int vn) const { int n = vn; if (vn < 1024) { const int i = vn >> 6, j = vn & 63; n = (j < 32) ? (32 * i + j) : (512 + 32 * i + (j - 32)); } return wt + (size_t)n * D; } };
__device__ __forceinline__ void proj_epi(const Params& p, int m0, int n0, f32x4 (&acc)[4][4], int lane) {
    bf16 *u = (bf16*)(p.ws + WS_U), *q = (bf16*)(p.ws + WS_Q), *k = (bf16*)(p.ws + WS_K), *vT = (bf16*)(p.ws + WS_VT), *sga = (bf16*)(p.ws + WS_SGA), *sgb = (bf16*)(p.ws + WS_SGB);
    const int g = lane >> 4, li = lane & 15, vt = n0 >> 6;
#pragma unroll
    for (int mt = 0; mt < 4; ++mt) {
        const int m = m0 + 16 * mt + li;
        if (vt < 16) {
#pragma unroll
            for (int nt = 0; nt < 2; ++nt) { f32x4 a = acc[mt][nt], gt = acc[mt][nt + 2]; u32x2 w;
                w.x = pk2(a.x * sigmoidf_(gt.x), a.y * sigmoidf_(gt.y)); w.y = pk2(a.z * sigmoidf_(gt.z), a.w * sigmoidf_(gt.w));
                *(u32x2*)(u + (size_t)m * DC + 32 * vt + 16 * nt + 4 * g) = w; }
        } else if (vt < 32) {
            const bool isq = vt < 24; const int hh = isq ? vt - 16 : vt - 24; float ss = 0.f;
#pragma unroll
            for (int nt = 0; nt < 4; ++nt) { f32x4 v = acc[mt][nt]; ss += (v.x * v.x + v.y * v.y) + (v.z * v.z + v.w * v.w); }
            ss += __shfl_xor(ss, 16); ss += __shfl_xor(ss, 32);
            const float rs = rsqrtf(ss * (1.f / 64.f) + EPS) * (isq ? 0.125f : 1.f);
            const float* gg = isq ? p.q_norm_g : p.k_norm_g; bf16* o = (isq ? q : k) + (size_t)m * 512 + hh * 64;
#pragma unroll
            for (int nt = 0; nt < 4; ++nt) { f32x4 v = acc[mt][nt]; const f32x4 gv = *(const f32x4*)(gg + 16 * nt + 4 * g); u32x2 w;
                w.x = pk2(v.x * rs * gv.x, v.y * rs * gv.y); w.y = pk2(v.z * rs * gv.z, v.w * rs * gv.w); *(u32x2*)(o + 16 * nt + 4 * g) = w; }
        } else if (vt < 40) {
            const int hh = vt - 32;
#pragma unroll
            for (int nt = 0; nt < 4; ++nt)
#pragma unroll
                for (int r = 0; r < 4; ++r) vT[(size_t)(hh * 64 + 16 * nt + 4 * g + r) * S + m] = (bf16)f2bf(acc[mt][nt][r]);
        } else {
            bf16* o = (vt < 56 ? sga + (size_t)m * D + (vt - 40) * 64 : sgb + (size_t)m * D + (vt - 56) * 64);
#pragma unroll
            for (int nt = 0; nt < 4; ++nt) { f32x4 v = acc[mt][nt]; u32x2 w; w.x = pk2(sigmoidf_(v.x), sigmoidf_(v.y)); w.y = pk2(sigmoidf_(v.z), sigmoidf_(v.w));
                *(u32x2*)(o + 16 * nt + 4 * g) = w; }
        }
    }
}

__device__ __forceinline__ void conv_phase(const Params& p, unsigned char* lds, int G, int WID) {
    const bf16* u = (const bf16*)(p.ws + WS_U); bf16* u2 = (bf16*)(p.ws + WS_U2);
    unsigned char* ut = lds; float* cv = (float*)(lds + 65536);
    const int tid = otid(WID), cp = tid & 255, half = tid >> 8, wave = tid >> 6, lane = tid & 63;
    float w0[31], w1[31];
#pragma unroll
    for (int j = 0; j < 31; ++j) { const float2 wv = *(const float2*)(p.conv_w + j * DC + 2 * cp); w0[j] = wv.x; w1[j] = wv.y; }
    const float2 bv = *(const float2*)(p.conv_b + 2 * cp);
    for (int rep = 0; rep < REPS(20); ++rep)
    for (int item = blockIdx.x; item < S / 32; item += G) {
        const int t0 = item * 32;
#pragma unroll
        for (int j = 0; j < 8; ++j) { const int pc = tid + 512 * j; if (pc < 62 * 64) { const int row = pc >> 6, c16 = pc & 63, tt = t0 - 15 + row; u32x4 v = (u32x4){0u, 0u, 0u, 0u};
            if (tt >= 0 && tt < S) v = *(const u32x4*)(u + (size_t)tt * DC + c16 * 8); *(u32x4*)(ut + row * 1024 + c16 * 16) = v; } }
        __syncthreads();
#pragma unroll 1
        for (int hp = 0; hp < 2; ++hp) {
            float a0[8], a1[8];
#pragma unroll
            for (int t = 0; t < 8; ++t) { a0[t] = bv.x; a1[t] = bv.y; }
            const unsigned char* up = ut + (half * 16 + hp * 8) * 1024 + 4 * cp;
#pragma unroll
            for (int i = 0; i < 38; ++i) { const unsigned v = *(const unsigned*)(up + i * 1024); const float x0 = bf2f(v & 0xffff), x1 = bf2f(v >> 16);
#pragma unroll
                for (int t = 0; t < 8; ++t) { const int j = i - t; if (j >= 0 && j < 31) { a0[t] += w0[j] * x0; a1[t] += w1[j] * x1; } } }
#pragma unroll
            for (int t = 0; t < 8; ++t) *(float2*)(cv + (half * 16 + hp * 8 + t) * DC + 2 * cp) = make_float2(a0[t], a1[t]);
        }
        __syncthreads();
#pragma unroll
        for (int q = 0; q < 4; ++q) {
            const int tl = wave * 4 + q; const float* row = cv + tl * DC;
            f32x4 v0 = *(const f32x4*)(row + 8 * lane), v1 = *(const f32x4*)(row + 8 * lane + 4);
            const float mean = wave_sum((v0.x + v0.y) + (v0.z + v0.w) + (v1.x + v1.y) + (v1.z + v1.w)) * (1.f / DC);
            v0 = v0 - mean; v1 = v1 - mean;
            const float var = wave_sum((v0.x * v0.x + v0.y * v0.y) + (v0.z * v0.z + v0.w * v0.w) + (v1.x * v1.x + v1.y * v1.y) + (v1.z * v1.z + v1.w * v1.w)) * (1.f / DC);
            const float rstd = rsqrtf(var + EPS);
            const f32x4 g0 = *(const f32x4*)(p.ln_g + 8 * lane), g1 = *(const f32x4*)(p.ln_g + 8 * lane + 4), b0 = *(const f32x4*)(p.ln_b + 8 * lane), b1 = *(const f32x4*)(p.ln_b + 8 * lane + 4);
            v0 = v0 * rstd * g0 + b0; v1 = v1 * rstd * g1 + b1;
            u32x4 w; w.x = pk2(v0.x * sigmoidf_(v0.x), v0.y * sigmoidf_(v0.y)); w.y = pk2(v0.z * sigmoidf_(v0.z), v0.w * sigmoidf_(v0.w));
            w.z = pk2(v1.x * sigmoidf_(v1.x), v1.y * sigmoidf_(v1.y)); w.w = pk2(v1.z * sigmoidf_(v1.z), v1.w * sigmoidf_(v1.w));
            *(u32x4*)(u2 + (size_t)(t0 + tl) * D + 8 * lane) = w;
        }
        __syncthreads();
    }
}

__device__ __forceinline__ void attn_wave(const bf16* q, const bf16* k, const bf16* vT, const float* rpb, bf16* ao, int r, int h, int qb, int lane) {
    const int g = lane >> 4, qi = lane & 15, c0 = 16 * qb, c = c0 + qi;
    int cs = c0 - 8; cs = cs < 0 ? 0 : (cs > 32 ? 32 : cs);
    int colst = c - 8; colst = colst < 0 ? 0 : (colst > 48 ? 48 : colst);
    int rs = r - 4; rs = rs < 0 ? 0 : (rs > ROWS - 8 ? ROWS - 8 : rs);
    const bf16* qp = q + (size_t)(r * 64 + c) * 512 + h * 64 + 8 * g;
    const bf16x8 bq0 = *(const bf16x8*)qp, bq1 = *(const bf16x8*)(qp + 32);
    const int kk = 8 * (qi >> 2) + (qi & 3);
    float sc[8][2][4]; float mx = -3.0e38f;
#pragma unroll
    for (int i = 0; i < 8; ++i) {
        const float* bias_row = rpb + (size_t)(h * 15 + (rs + i - r + 7)) * 31;
#pragma unroll
        for (int T = 0; T < 2; ++T) {
            const bf16* kp = k + (size_t)((rs + i) * 64 + cs + kk + 4 * T) * 512 + h * 64 + 8 * g;
            f32x4 acc = (f32x4){0.f, 0.f, 0.f, 0.f};
            acc = __builtin_amdgcn_mfma_f32_16x16x32_bf16(*(const bf16x8*)kp, bq0, acc, 0, 0, 0);
            acc = __builtin_amdgcn_mfma_f32_16x16x32_bf16(*(const bf16x8*)(kp + 32), bq1, acc, 0, 0, 0);
#pragma unroll
            for (int rr = 0; rr < 4; ++rr) {
                const int kc = cs + 8 * g + rr + 4 * T; const bool valid = (kc >= colst) && (kc < colst + 16);
                int bi = kc - c + 15; bi = bi < 0 ? 0 : (bi > 30 ? 30 : bi);
                const float s = valid ? acc[rr] + bias_row[bi] : -3.0e38f;
                sc[i][T][rr] = s; mx = fmaxf(mx, s);
            }
        }
    }
    mx = fmaxf(mx, __shfl_xor(mx, 16)); mx = fmaxf(mx, __shfl_xor(mx, 32));
    float sum = 0.f;
#pragma unroll
    for (int i = 0; i < 8; ++i)
#pragma unroll
        for (int T = 0; T < 2; ++T)
#pragma unroll
            for (int rr = 0; rr < 4; ++rr) { const float s = sc[i][T][rr]; const float e = (s > -1.0e38f) ? __expf(s - mx) : 0.f; sc[i][T][rr] = e; sum += e; }
    sum += __shfl_xor(sum, 16); sum += __shfl_xor(sum, 32);
    const float inv = 1.f / sum;
    f32x4 o[4];
#pragma unroll
    for (int n = 0; n < 4; ++n) o[n] = (f32x4){0.f, 0.f, 0.f, 0.f};
#pragma unroll
    for (int i = 0; i < 8; ++i) {
        union { bf16x8 v; unsigned w[4]; } pb;
        pb.w[0] = pk2(sc[i][0][0], sc[i][0][1]); pb.w[1] = pk2(sc[i][0][2], sc[i][0][3]); pb.w[2] = pk2(sc[i][1][0], sc[i][1][1]); pb.w[3] = pk2(sc[i][1][2], sc[i][1][3]);
#pragma unroll
        for (int n = 0; n < 4; ++n) {
            const bf16x8 av = *(const bf16x8*)(vT + (size_t)(h * 64 + 16 * n + qi) * S + (rs + i) * 64 + cs + 8 * g);
            o[n] = __builtin_amdgcn_mfma_f32_16x16x32_bf16(av, pb.v, o[n], 0, 0, 0);
        }
    }
    bf16* op = ao + (size_t)(r * 64 + c) * D + 512 + h * 64 + 4 * g;
#pragma unroll
    for (int n = 0; n < 4; ++n) { u32x2 w; w.x = pk2(o[n].x * inv, o[n].y * inv); w.y = pk2(o[n].z * inv, o[n].w * inv); *(u32x2*)(op + 16 * n) = w; }
}


__device__ __forceinline__ void attn_phase(const Params& p, unsigned char* lds, int G, int WID) {
    const bf16* q = (const bf16*)(p.ws + WS_Q); const bf16* kk_ = (const bf16*)(p.ws + WS_K); const bf16* vT = (const bf16*)(p.ws + WS_VT); bf16* ao = (bf16*)(p.ws + WS_AO);
    unsigned char* kr = lds; unsigned char* vr = lds + 65536; float* xch = (float*)(lds + 131072); float* bt = (float*)(lds + 131072 + 10240);
    const int tid = otid(WID), lane = tid & 63, wave = owid(WID), g = lane >> 4, qi = lane & 15, qb = wave & 3, kh = wave >> 2;
    const int srow = tid >> 3, sch = tid & 7;
    const int c0 = 16 * qb, c = c0 + qi;
    int cs = c0 - 8; cs = cs < 0 ? 0 : (cs > 32 ? 32 : cs);
    int colst = c - 8; colst = colst < 0 ? 0 : (colst > 48 ? 48 : colst);
    const int kcol = 8 * (qi >> 2) + (qi & 3);
    int bofs[2][4]; unsigned vmask = 0u;
#pragma unroll
    for (int T = 0; T < 2; ++T)
#pragma unroll
        for (int rr = 0; rr < 4; ++rr) { const int kc = cs + 8 * g + rr + 4 * T; if ((kc >= colst) && (kc < colst + 16)) vmask |= 1u << (4 * T + rr); int bi = kc - c + 15; bofs[T][rr] = bi < 0 ? 0 : (bi > 30 ? 30 : bi); }
    for (int unit = blockIdx.x; unit < NH * (ROWS / 8); unit += G) {
        const int h = unit & 7, r0 = (unit >> 3) * 8;
        __syncthreads();
        for (int i = tid; i < 15 * 31; i += NTHR) bt[i] = p.rpb[h * 465 + i] * 1.44269504089f;
        int rs0 = r0 - 4; rs0 = rs0 < 0 ? 0 : (rs0 > ROWS - 8 ? ROWS - 8 : rs0);
#pragma unroll
        for (int j = 0; j < 8; ++j) { const int krow = rs0 + j, sl = krow & 7;
            const u32x4 a = *(const u32x4*)(kk_ + (size_t)(krow * 64 + srow) * 512 + h * 64 + sch * 8), b = *(const u32x4*)(vT + (size_t)(h * 64 + srow) * S + krow * 64 + sch * 8);
            *(u32x4*)(kr + sl * 8192 + srow * 128 + ((sch ^ (srow & 7)) << 4)) = a; *(u32x4*)(vr + sl * 8192 + srow * 128 + ((sch ^ (srow & 7)) << 4)) = b; }
        __syncthreads();
        bf16x8 bq0, bq1;
        { const bf16* qp = q + (size_t)(r0 * 64 + c) * 512 + h * 64 + 8 * g; bq0 = *(const bf16x8*)qp; bq1 = *(const bf16x8*)(qp + 32); }
#pragma unroll 1
        for (int j = 0; j < 8; ++j) {
            const int r = r0 + j; int rs = r - 4; rs = rs < 0 ? 0 : (rs > ROWS - 8 ? ROWS - 8 : rs);
            int rsn = r + 1 - 4; rsn = rsn < 0 ? 0 : (rsn > ROWS - 8 ? ROWS - 8 : rsn);
            const bool pf = (j < 7) && (rsn != rs);
            u32x4 pa = (u32x4){0u, 0u, 0u, 0u}, pb = pa;
            if (pf) { const int krow = rsn + 7; pa = *(const u32x4*)(kk_ + (size_t)(krow * 64 + srow) * 512 + h * 64 + sch * 8); pb = *(const u32x4*)(vT + (size_t)(h * 64 + srow) * S + krow * 64 + sch * 8); }
            bf16x8 nq0 = bq0, nq1 = bq1;
            if (j < 7) { const bf16* qp = q + (size_t)((r + 1) * 64 + c) * 512 + h * 64 + 8 * g; nq0 = *(const bf16x8*)qp; nq1 = *(const bf16x8*)(qp + 32); }
            float sc[4][2][4]; float mx = -3.0e38f;
#pragma unroll
            for (int i4 = 0; i4 < 4; ++i4) {
                const int i = 4 * kh + i4, sl = (rs + i) & 7; const float* brow = bt + (rs + i - r + 7) * 31;
#pragma unroll
                for (int T = 0; T < 2; ++T) {
                    const int col = cs + kcol + 4 * T; const unsigned char* kp = kr + sl * 8192 + col * 128;
                    const bf16x8 k0 = *(const bf16x8*)(kp + (((g) ^ (col & 7)) << 4)), k1 = *(const bf16x8*)(kp + (((4 + g) ^ (col & 7)) << 4));
                    f32x4 acc = (f32x4){0.f, 0.f, 0.f, 0.f};
                    acc = __builtin_amdgcn_mfma_f32_16x16x32_bf16(k0, bq0, acc, 0, 0, 0);
                    acc = __builtin_amdgcn_mfma_f32_16x16x32_bf16(k1, bq1, acc, 0, 0, 0);
#pragma unroll
                    for (int rr = 0; rr < 4; ++rr) {
                        const float sv = ((vmask >> (4 * T + rr)) & 1u) ? acc[rr] + brow[bofs[T][rr]] : -3.0e38f;
                        sc[i4][T][rr] = sv; mx = fmaxf(mx, sv);
                    }
                }
            }
            mx = fmaxf(mx, __shfl_xor(mx, 16)); mx = fmaxf(mx, __shfl_xor(mx, 32));
            float sum = 0.f;
#pragma unroll
            for (int i4 = 0; i4 < 4; ++i4)
#pragma unroll
                for (int T = 0; T < 2; ++T)
#pragma unroll
                    for (int rr = 0; rr < 4; ++rr) { const float e = __builtin_amdgcn_exp2f(sc[i4][T][rr] - mx); sc[i4][T][rr] = e; sum += e; }
            sum += __shfl_xor(sum, 16); sum += __shfl_xor(sum, 32);
            f32x4 o[4];
#pragma unroll
            for (int n = 0; n < 4; ++n) o[n] = (f32x4){0.f, 0.f, 0.f, 0.f};
#pragma unroll
            for (int i4 = 0; i4 < 4; ++i4) {
                const int sl = (rs + 4 * kh + i4) & 7;
                union { bf16x8 v; unsigned w[4]; } pb2;
                pb2.w[0] = pk2(sc[i4][0][0], sc[i4][0][1]); pb2.w[1] = pk2(sc[i4][0][2], sc[i4][0][3]); pb2.w[2] = pk2(sc[i4][1][0], sc[i4][1][1]); pb2.w[3] = pk2(sc[i4][1][2], sc[i4][1][3]);
#pragma unroll
                for (int n = 0; n < 4; ++n) { const int d = 16 * n + qi;
                    const bf16x8 av = *(const bf16x8*)(vr + sl * 8192 + d * 128 + ((((cs >> 3) + g) ^ (d & 7)) << 4));
                    o[n] = __builtin_amdgcn_mfma_f32_16x16x32_bf16(av, pb2.v, o[n], 0, 0, 0); }
            }
            if (kh == 1) {
                float* x = xch + qb * 640 + lane; x[0] = mx; x[64] = sum;
#pragma unroll
                for (int n = 0; n < 4; ++n) { x[(2 + 2 * n) * 64] = __uint_as_float(pk2(o[n][0], o[n][1])); x[(3 + 2 * n) * 64] = __uint_as_float(pk2(o[n][2], o[n][3])); }
            }
            __syncthreads();
            if (pf) { const int sl = (rsn + 7) & 7; *(u32x4*)(kr + sl * 8192 + srow * 128 + ((sch ^ (srow & 7)) << 4)) = pa; *(u32x4*)(vr + sl * 8192 + srow * 128 + ((sch ^ (srow & 7)) << 4)) = pb; }
            if (kh == 0) {
                const float* x = xch + qb * 640 + lane; const float mB = x[0], lB = x[64];
                const float m = fmaxf(mx, mB), fa = __builtin_amdgcn_exp2f(mx - m), fb = __builtin_amdgcn_exp2f(mB - m), inv = 1.f / (sum * fa + lB * fb);
                bf16* op = ao + (size_t)(r * 64 + c) * D + 512 + h * 64 + 4 * g;
#pragma unroll
                for (int n = 0; n < 4; ++n) { const unsigned w0 = __float_as_uint(x[(2 + 2 * n) * 64]), w1 = __float_as_uint(x[(3 + 2 * n) * 64]);
                    const float v0 = (o[n][0] * fa + bf2f(w0 & 0xffff) * fb) * inv, v1 = (o[n][1] * fa + bf2f(w0 >> 16) * fb) * inv, v2 = (o[n][2] * fa + bf2f(w1 & 0xffff) * fb) * inv, v3 = (o[n][3] * fa + bf2f(w1 >> 16) * fb) * inv;
                    u32x2 w; w.x = pk2(v0, v1); w.y = pk2(v2, v3); *(u32x2*)(op + 16 * n) = w; }
            }
            __syncthreads();
            bq0 = nq0; bq1 = nq1;
        }
    }
}


namespace pg8 {
constexpr int BM = 256, BK = 64, HALF = 128, HTB = HALF * BK * 2;
__device__ __forceinline__ int lds_byte(int r, int c) { const int st = (r >> 4) * 2 + (c >> 5), rr = r & 15, cc = c & 31, ob = rr * 64 + cc * 2; return st * 1024 + (ob ^ (((ob >> 9) & 1) << 5)); }
__device__ __forceinline__ void stage_rc(int b, int& R, int& C) { const int st = b / 1024, sb = b % 1024, swz = sb ^ (((sb >> 9) & 1) << 5); R = (st >> 1) * 16 + swz / 64; C = (st & 1) * 32 + (swz % 64) / 2; }
__device__ __forceinline__ int perm32(int rho) { const int n = rho >> 4, i = rho & 15; return 8 * (i >> 2) + 4 * n + (i & 3); }
__device__ __forceinline__ unsigned cvt_pk_bf16(float lo, float hi) { return pk2(lo, hi); }
struct Unit { int pm, pn, e, slot; };
typedef f32x4 Acc[2][2][4][2];

template <class Epi, class Sched, bool ALIGN_EPI>
__device__ __forceinline__ void gemm_phase(LAS unsigned char* lds, const char* A, int K, const Sched& S, const Epi& E, int WID) {
    int tid_ = otid(WID);
    const int tid = tid_, wid = owid(WID), lane = tid & 63, wr = wid >> 2, wc = wid & 3, fr = lane & 15, fq = lane >> 4;
    const int nt = K / BK;
    unsigned voffB[2];
#pragma unroll
    for (int i = 0; i < 2; ++i) { int R, C; stage_rc(tid * 16 + i * 8192, R, C); const int Rb = (R & ~31) + perm32(R & 31); voffB[i] = (unsigned)(Rb * K + C) * 2u; }
#define PG8_AOFFS(un, o00, o01, o10, o11) do { int t2_ = tid; asm volatile("" : "+v"(t2_)); int R0_, C0_, R1_, C1_; stage_rc(t2_ * 16, R0_, C0_); stage_rc(t2_ * 16 + 8192, R1_, C1_); const unsigned ko_ = S.a_koff(un); \
        o00 = S.a_off(un, R0_) + ko_ + (unsigned)C0_ * 2u; o01 = S.a_off(un, R1_) + ko_ + (unsigned)C1_ * 2u; o10 = S.a_off(un, HALF + R0_) + ko_ + (unsigned)C0_ * 2u; o11 = S.a_off(un, HALF + R1_) + ko_ + (unsigned)C1_ * 2u; } while (0)
    const size_t kstep = (size_t)(BK * 2);
    const size_t hstepB = (size_t)HALF * K * 2;
    const unsigned ldsw = (unsigned)wid * 1024u;
    const int aoff = lds_byte(wr * 64 + fr, fq * 8), boff = lds_byte(wc * 32 + fr, fq * 8);
#define PG8_SA(b, h) (((b) * 2 + (h)) * HTB)
#define PG8_SB(b, h) ((4 + (b) * 2 + (h)) * HTB)
#define PG8_STAGE(bufoff, gbase, v0, v1) do { \
        __builtin_amdgcn_global_load_lds((const unsigned*)((const char*)(gbase) + (v0)), (LAS unsigned*)(lds + (bufoff) + ldsw), 16, 0, 0); \
        __builtin_amdgcn_global_load_lds((const unsigned*)((const char*)(gbase) + (v1)), (LAS unsigned*)(lds + (bufoff) + ldsw + 8192), 16, 0, 0); } while (0)
#define PG8_LDA(dst, b, h) do { _Pragma("unroll") for (int m = 0; m < 4; ++m) _Pragma("unroll") for (int k = 0; k < 2; ++k) dst[m][k] = *(const LAS bf16x8*)(lds + PG8_SA(b, h) + aoff + m * 2048 + k * 1024); } while (0)
#define PG8_LDB(dst, b, h) do { _Pragma("unroll") for (int n = 0; n < 2; ++n) _Pragma("unroll") for (int k = 0; k < 2; ++k) dst[n][k] = *(const LAS bf16x8*)(lds + PG8_SB(b, h) + boff + n * 2048 + k * 1024); } while (0)
#define PG8_MMA(ai, bj, At, Bt) do { __builtin_amdgcn_s_setprio(1); _Pragma("unroll") for (int m = 0; m < 4; ++m) _Pragma("unroll") for (int n = 0; n < 2; ++n) _Pragma("unroll") for (int k = 0; k < 2; ++k) \
        acc[ai][bj][m][n] = __builtin_amdgcn_mfma_f32_16x16x32_bf16(Bt[n][k], At[m][k], acc[ai][bj][m][n], 0, 0, 0); __builtin_amdgcn_s_setprio(0); } while (0)
#define PG8_WAIT_V(n) asm volatile("s_waitcnt vmcnt(" #n ")" ::: "memory")
#define PG8_WAIT_L(n) asm volatile("s_waitcnt lgkmcnt(" #n ")" ::: "memory")
#define PG8_BAR __builtin_amdgcn_s_barrier()
#define PG8_SCHED __builtin_amdgcn_sched_barrier(0)
#define PG8_ZERO() do { _Pragma("unroll") for (int a = 0; a < 2; ++a) _Pragma("unroll") for (int b = 0; b < 2; ++b) _Pragma("unroll") for (int m = 0; m < 4; ++m) _Pragma("unroll") for (int n = 0; n < 2; ++n) acc[a][b][m][n] = (f32x4){0.f, 0.f, 0.f, 0.f}; } while (0)
    __builtin_amdgcn_sched_barrier(0);
    Unit cur, nxt; int ui = 0;
    if (!S.next(0, cur)) return;
    Acc acc; PG8_ZERO();
    bf16x8 At[4][2], B0[2][2], B1[2][2];
    unsigned c00, c01, c10, c11, n00, n01, n10, n11;
    PG8_AOFFS(cur, c00, c01, c10, c11);
    const char* cB = S.b_ptr(cur);
    PG8_STAGE(PG8_SB(0, 0), cB, voffB[0], voffB[1]); PG8_STAGE(PG8_SB(0, 1), cB + hstepB, voffB[0], voffB[1]); PG8_STAGE(PG8_SA(0, 0), A, c00, c01); PG8_STAGE(PG8_SA(0, 1), A, c10, c11);
    if (wr == 1) PG8_BAR;
    PG8_WAIT_V(2); PG8_BAR;
    PG8_STAGE(PG8_SB(1, 0), cB + kstep, voffB[0], voffB[1]); PG8_STAGE(PG8_SA(1, 0), A + kstep, c00, c01); PG8_STAGE(PG8_SB(1, 1), cB + hstepB + kstep, voffB[0], voffB[1]);
    PG8_WAIT_V(6); PG8_BAR;
    for (;;) {
        const bool has_next = S.next(ui + 1, nxt);
        const char* nB = cB; n00 = c00; n01 = c01; n10 = c10; n11 = c11;
        if (has_next) { PG8_AOFFS(nxt, n00, n01, n10, n11); nB = S.b_ptr(nxt); }
#define PG8_KBODY(t, last) do { \
            const char* a1 = A + (size_t)(t + 1) * kstep; \
            const char* a2 = last ? A : A + (size_t)(t + 2) * kstep; const char* b2 = last ? nB : cB + (size_t)(t + 2) * kstep; \
            const char* a3 = a2 + kstep; const char* b3 = b2 + kstep; \
            const unsigned s00 = last ? n00 : c00, s01 = last ? n01 : c01, s10 = last ? n10 : c10, s11 = last ? n11 : c11; \
            PG8_LDB(B0, 0, 0); PG8_LDB(B1, 0, 1); PG8_SCHED; PG8_LDA(At, 0, 0); PG8_STAGE(PG8_SA(1, 1), a1, c10, c11); \
            PG8_WAIT_V(8); PG8_WAIT_L(0); PG8_BAR; PG8_MMA(0, 0, At, B0); PG8_MMA(0, 1, At, B1); PG8_BAR; PG8_SCHED; \
            PG8_LDA(At, 0, 1); PG8_STAGE(PG8_SB(0, 0), b2, voffB[0], voffB[1]); PG8_STAGE(PG8_SB(0, 1), b2 + hstepB, voffB[0], voffB[1]); PG8_STAGE(PG8_SA(0, 0), a2, s00, s01); \
            PG8_WAIT_V(8); PG8_WAIT_L(0); PG8_BAR; PG8_MMA(1, 0, At, B0); PG8_MMA(1, 1, At, B1); PG8_BAR; PG8_SCHED; \
            PG8_LDB(B0, 1, 0); PG8_LDB(B1, 1, 1); PG8_SCHED; PG8_LDA(At, 1, 0); PG8_STAGE(PG8_SA(0, 1), a2, s10, s11); \
            PG8_WAIT_V(8); PG8_WAIT_L(0); PG8_BAR; PG8_MMA(0, 0, At, B0); PG8_MMA(0, 1, At, B1); PG8_BAR; PG8_SCHED; \
            PG8_LDA(At, 1, 1); PG8_STAGE(PG8_SB(1, 0), b3, voffB[0], voffB[1]); PG8_STAGE(PG8_SB(1, 1), b3 + hstepB, voffB[0], voffB[1]); PG8_STAGE(PG8_SA(1, 0), a3, s00, s01); \
            PG8_WAIT_V(8); PG8_WAIT_L(0); PG8_BAR; PG8_MMA(1, 0, At, B0); PG8_MMA(1, 1, At, B1); PG8_BAR; PG8_SCHED; \
        } while (0)
        if (Epi::HAS_MID) {
            _Pragma("unroll 1") for (int t = 0; t < nt / 2; t += 2) PG8_KBODY(t, false);
            E.mid(acc, cur, wr, wc, fr, fq);
            _Pragma("unroll 1") for (int t = nt / 2; t < nt; t += 2) { const bool lastq = (t == nt - 2); PG8_KBODY(t, lastq); }
        } else {
            _Pragma("unroll 1") for (int t = 0; t < nt; t += 2) { const bool lastq = (t == nt - 2); PG8_KBODY(t, lastq); }
        }
#undef PG8_KBODY
        if (ALIGN_EPI) { if (wr == 0) PG8_BAR; }
        { int t3 = tid; asm volatile("" : "+v"(t3)); const int l3 = t3 & 63; E(acc, cur, wr, wc, l3 & 15, l3 >> 4); }
        if (!has_next) break;
        PG8_ZERO();
        cur = nxt; cB = nB; c00 = n00; c01 = n01; c10 = n10; c11 = n11; ++ui;
        if (ALIGN_EPI) { if (wr == 1) PG8_BAR; }
    }
    PG8_WAIT_V(0);
    if (!ALIGN_EPI) { if (wr == 0) PG8_BAR; }
    PG8_BAR;
#undef PG8_SA
#undef PG8_SB
#undef PG8_STAGE
#undef PG8_LDA
#undef PG8_LDB
#undef PG8_MMA
#undef PG8_WAIT_V
#undef PG8_WAIT_L
#undef PG8_BAR
#undef PG8_SCHED
#undef PG8_ZERO
#undef PG8_AOFFS
}
struct DenseOrder {
    int nM, nN, nwg, G, c; unsigned lda2; const char* Bt; size_t btile;
    __device__ __forceinline__ void init(int M, int N, int K, int lda, const void* Bt_, int G_, int c_) { nM = M / BM; nN = N / BM; nwg = nM * nN; G = G_; c = c_; lda2 = (unsigned)lda * 2u; Bt = (const char*)Bt_; btile = (size_t)BM * K * 2; }
    __device__ __forceinline__ bool next(int i, Unit& u) const {
        const long L = (long)i * G + c; if (L >= nwg) return false;
        int wgid = (int)L; { const int q = nwg / 8, r = nwg % 8, xcd = wgid % 8, off = wgid / 8; wgid = (xcd < r ? xcd * (q + 1) : r * (q + 1) + (xcd - r) * q) + off; }
        const int nig = 8 * nN, gid = wgid / nig, fm = gid * 8, gsz = (nM - fm) < 8 ? (nM - fm) : 8;
        u.pm = fm + ((wgid % nig) % gsz); u.pn = (wgid % nig) / gsz; u.e = 0; u.slot = 0; return true;
    }
    __device__ __forceinline__ unsigned a_off(const Unit& u, int r) const { return (unsigned)(u.pm * BM + r) * lda2; }
    __device__ __forceinline__ unsigned a_koff(const Unit&) const { return 0u; }
    __device__ __forceinline__ const char* b_ptr(const Unit& u) const { return Bt + (size_t)u.pn * btile; }
};
struct EpiResid {
    static constexpr bool HAS_MID = false;
    const float* __restrict__ x; float* __restrict__ out; bf16* __restrict__ xb;
    __device__ __forceinline__ void mid(Acc&, const Unit&, int, int, int, int) const {}
    __device__ __forceinline__ void operator()(const Acc& acc, const Unit& u, int wr, int wc, int fr, int fq) const {
        const int row0 = u.pm * BM + wr * 64 + fr, col0 = u.pn * BM + wc * 32 + 8 * fq;
#pragma unroll
        for (int ai = 0; ai < 2; ++ai)
#pragma unroll
            for (int m = 0; m < 4; ++m) { const size_t ro = (size_t)(row0 + ai * HALF + m * 16) * D + col0;
                f32x4 xv[2][2];
#pragma unroll
                for (int bj = 0; bj < 2; ++bj)
#pragma unroll
                    for (int n = 0; n < 2; ++n) xv[bj][n] = __builtin_nontemporal_load((const f32x4*)(x + ro + bj * HALF + 4 * n));
#pragma unroll
                for (int bj = 0; bj < 2; ++bj) { const f32x4 v0 = xv[bj][0] + acc[ai][bj][m][0], v1 = xv[bj][1] + acc[ai][bj][m][1];
                    *(f32x4*)(out + ro + bj * HALF) = v0; *(f32x4*)(out + ro + bj * HALF + 4) = v1;
                    u32x4 w; w.x = cvt_pk_bf16(v0[0], v0[1]); w.y = cvt_pk_bf16(v0[2], v0[3]); w.z = cvt_pk_bf16(v1[0], v1[1]); w.w = cvt_pk_bf16(v1[2], v1[3]);
                    *(u32x4*)(xb + ro + bj * HALF) = w; } }
    }
};
__device__ __forceinline__ float sigm(float v) { return __builtin_amdgcn_rcpf(1.f + __expf(-v)); }
struct EpiProj {
    static constexpr bool HAS_MID = false;
    bf16 *u, *q, *k, *vT, *sga, *sgb; const float *qg, *kg;
    __device__ __forceinline__ void mid(Acc&, const Unit&, int, int, int, int) const {}
    __device__ __forceinline__ void operator()(const Acc& acc, const Unit& un, int wr, int wc, int fr, int fq) const {
        const int row0 = un.pm * BM + wr * 64 + fr, pn = un.pn;
        if (pn < 4) {
#pragma unroll
            for (int ai = 0; ai < 2; ++ai)
#pragma unroll
                for (int m = 0; m < 4; ++m) { const f32x4 a0 = acc[ai][0][m][0], a1 = acc[ai][0][m][1], g0 = acc[ai][1][m][0], g1 = acc[ai][1][m][1]; u32x4 w;
                    w.x = cvt_pk_bf16(a0[0] * sigm(g0[0]), a0[1] * sigm(g0[1])); w.y = cvt_pk_bf16(a0[2] * sigm(g0[2]), a0[3] * sigm(g0[3]));
                    w.z = cvt_pk_bf16(a1[0] * sigm(g1[0]), a1[1] * sigm(g1[1])); w.w = cvt_pk_bf16(a1[2] * sigm(g1[2]), a1[3] * sigm(g1[3]));
                    *(u32x4*)(u + (size_t)(row0 + ai * HALF + m * 16) * DC + 128 * pn + 32 * wc + 8 * fq) = w; }
        } else if (pn < 8) {
            const bool isq = pn < 6; const int hh = 4 * (pn & 1) + wc; const float* gg = isq ? qg : kg; bf16* dst = (isq ? q : k) + hh * 64 + 8 * fq; const float sc0 = isq ? 0.125f * 1.44269504089f : 1.f;
            f32x4 gv[2][2];
#pragma unroll
            for (int bj = 0; bj < 2; ++bj)
#pragma unroll
                for (int n = 0; n < 2; ++n) gv[bj][n] = *(const f32x4*)(gg + 32 * bj + 8 * fq + 4 * n);
#pragma unroll
            for (int ai = 0; ai < 2; ++ai)
#pragma unroll
                for (int m = 0; m < 4; ++m) { float ss = 0.f;
#pragma unroll
                    for (int bj = 0; bj < 2; ++bj)
#pragma unroll
                        for (int n = 0; n < 2; ++n) { const f32x4 v = acc[ai][bj][m][n]; ss += (v[0] * v[0] + v[1] * v[1]) + (v[2] * v[2] + v[3] * v[3]); }
                    ss += __shfl_xor(ss, 16); ss += __shfl_xor(ss, 32);
                    const float rs = rsqrtf(ss * (1.f / 64.f) + EPS) * sc0;
#pragma unroll
                    for (int bj = 0; bj < 2; ++bj) { const f32x4 v0 = acc[ai][bj][m][0] * gv[bj][0] * rs, v1 = acc[ai][bj][m][1] * gv[bj][1] * rs; u32x4 w;
                        w.x = cvt_pk_bf16(v0[0], v0[1]); w.y = cvt_pk_bf16(v0[2], v0[3]); w.z = cvt_pk_bf16(v1[0], v1[1]); w.w = cvt_pk_bf16(v1[2], v1[3]);
                        *(u32x4*)(dst + (size_t)(row0 + ai * HALF + m * 16) * 512 + 32 * bj) = w; } }
        } else if (pn < 10) {
            const int vc0 = 256 * (pn - 8) + 32 * wc + 8 * fq;
#pragma unroll
            for (int ai = 0; ai < 2; ++ai)
#pragma unroll
                for (int m = 0; m < 4; ++m)
#pragma unroll
                    for (int bj = 0; bj < 2; ++bj)
#pragma unroll
                        for (int n = 0; n < 2; ++n)
#pragma unroll
                            for (int i = 0; i < 4; ++i) vT[(size_t)(vc0 + 128 * bj + 4 * n + i) * S + row0 + ai * HALF + m * 16] = (bf16)f2bf(acc[ai][bj][m][n][i]);
        } else {
            bf16* dst = (pn < 14 ? sga : sgb) + 256 * ((pn - 10) & 3) + 32 * wc + 8 * fq;
#pragma unroll
            for (int ai = 0; ai < 2; ++ai)
#pragma unroll
                for (int m = 0; m < 4; ++m)
#pragma unroll
                    for (int bj = 0; bj < 2; ++bj) { const f32x4 v0 = acc[ai][bj][m][0], v1 = acc[ai][bj][m][1]; u32x4 w;
                        w.x = cvt_pk_bf16(sigm(v0[0]), sigm(v0[1])); w.y = cvt_pk_bf16(sigm(v0[2]), sigm(v0[3])); w.z = cvt_pk_bf16(sigm(v1[0]), sigm(v1[1])); w.w = cvt_pk_bf16(sigm(v1[2]), sigm(v1[3]));
                        *(u32x4*)(dst + (size_t)(row0 + ai * HALF + m * 16) * D + 128 * bj) = w; }
        }
    }
};
struct EpiMerge {
    static constexpr bool HAS_MID = true;
    const bf16* __restrict__ sga; const bf16* __restrict__ sgb; bf16* __restrict__ mrg;
    static __device__ __forceinline__ float lo(unsigned w) { return __uint_as_float(w << 16); }
    static __device__ __forceinline__ float hi(unsigned w) { return __uint_as_float(w & 0xffff0000u); }
    __device__ __forceinline__ void mid(Acc& acc, const Unit& un, int wr, int wc, int fr, int fq) const {
        const size_t o0 = (size_t)(un.pm * BM + wr * 64 + fr) * D + un.pn * BM + 32 * wc + 8 * fq;
#pragma unroll
        for (int ai = 0; ai < 2; ++ai)
#pragma unroll
            for (int m = 0; m < 4; ++m)
#pragma unroll
                for (int bj = 0; bj < 2; ++bj) { const size_t off = o0 + (size_t)(ai * HALF + m * 16) * D + 128 * bj; const u32x4 a = __builtin_nontemporal_load((const u32x4*)(sga + off)), b = *(const u32x4*)(sgb + off);
                    f32x4& v0 = acc[ai][bj][m][0]; f32x4& v1 = acc[ai][bj][m][1];
                    v0[0] *= lo(a.x) * __builtin_amdgcn_rcpf(fmaxf(lo(b.x), 1e-6f)); v0[1] *= hi(a.x) * __builtin_amdgcn_rcpf(fmaxf(hi(b.x), 1e-6f));
                    v0[2] *= lo(a.y) * __builtin_amdgcn_rcpf(fmaxf(lo(b.y), 1e-6f)); v0[3] *= hi(a.y) * __builtin_amdgcn_rcpf(fmaxf(hi(b.y), 1e-6f));
                    v1[0] *= lo(a.z) * __builtin_amdgcn_rcpf(fmaxf(lo(b.z), 1e-6f)); v1[1] *= hi(a.z) * __builtin_amdgcn_rcpf(fmaxf(hi(b.z), 1e-6f));
                    v1[2] *= lo(a.w) * __builtin_amdgcn_rcpf(fmaxf(lo(b.w), 1e-6f)); v1[3] *= hi(a.w) * __builtin_amdgcn_rcpf(fmaxf(hi(b.w), 1e-6f));
                    asm volatile("" ::: "memory"); }
    }
    __device__ __forceinline__ void operator()(const Acc& acc, const Unit& un, int wr, int wc, int fr, int fq) const {
        const size_t o0 = (size_t)(un.pm * BM + wr * 64 + fr) * D + un.pn * BM + 32 * wc + 8 * fq;
#pragma unroll
        for (int ai = 0; ai < 2; ++ai)
#pragma unroll
            for (int m = 0; m < 4; ++m) { u32x4 b[2];
#pragma unroll
                for (int bj = 0; bj < 2; ++bj) b[bj] = *(const u32x4*)(sgb + o0 + (size_t)(ai * HALF + m * 16) * D + 128 * bj);
#pragma unroll
                for (int bj = 0; bj < 2; ++bj) { const f32x4 v0 = acc[ai][bj][m][0], v1 = acc[ai][bj][m][1]; const u32x4 bb = b[bj]; u32x4 w;
                    w.x = cvt_pk_bf16(v0[0] * fmaxf(lo(bb.x), 1e-6f), v0[1] * fmaxf(hi(bb.x), 1e-6f)); w.y = cvt_pk_bf16(v0[2] * fmaxf(lo(bb.y), 1e-6f), v0[3] * fmaxf(hi(bb.y), 1e-6f));
                    w.z = cvt_pk_bf16(v1[0] * fmaxf(lo(bb.z), 1e-6f), v1[1] * fmaxf(hi(bb.z), 1e-6f)); w.w = cvt_pk_bf16(v1[2] * fmaxf(lo(bb.w), 1e-6f), v1[3] * fmaxf(hi(bb.w), 1e-6f));
                    *(u32x4*)(mrg + o0 + (size_t)(ai * HALF + m * 16) * D + 128 * bj) = w; } }
    }
};

template <int MU, bool ROWS> struct MoeOrder {
    int nu; unsigned lda2; const char* Bt; unsigned estride, tstride;
    LAS int* ddesc; LAS int* drow; LAS float* dscale;
    static_assert(512 + MU * 1024 * (ROWS ? 2 : 1) <= LDS_CTL_OFF - AUX_OFF, "aux LDS");
    __device__ __forceinline__ void init(int G, int c, const int* ctl, int NP, int pn0, int NPS, const int* stok, const float* rowscale, bool shared_one, unsigned lda2_, const void* Bt_, unsigned brow, int rows_e, LAS unsigned char* aux, int WID) {
        const int R = G >> 3, x = c & 7, r = c >> 3;
        const int tid0 = otid(WID); int ent = 0; if (tid0 < MU) { const int k0 = r + R * tid0; ent = ldc(ctl + C_XL + x * MAXT + (k0 / NP < MAXT ? k0 / NP : MAXT - 1)); }
        const int xn = ldc(ctl + C_XN + x);
        lda2 = lda2_; Bt = (const char*)Bt_; estride = (unsigned)rows_e * brow; tstride = (unsigned)BM * brow;
        ddesc = (LAS int*)aux; drow = (LAS int*)(aux + 512); dscale = (LAS float*)(aux + 512 + (ROWS ? MU * 1024 : 0));
        const int tid = tid0; const int total = xn * NP + 8 * NPS;
        nu = 0; if (r < R) for (int k = r; k < total && nu < MU; k += R) ++nu;
        if (tid < MU) { int k = r + R * tid, pm = 0, pn = 0, e = NE, ok = 0;
            if (tid < nu) { ok = 1;
                if (k < xn * NP) { pm = ent & 0xffff; pn = pn0 + k % NP; e = ent >> 16; }
                else { k -= xn * NP; pm = MAXT + x * 8 + k / NPS; pn = pn0 + k % NPS; e = NE; } }
            ddesc[4 * tid + 0] = pm; ddesc[4 * tid + 1] = pn; ddesc[4 * tid + 2] = e; ddesc[4 * tid + 3] = ok; }
        __syncthreads();
        for (int j = 0; j < nu; ++j) { const int pm = ddesc[4 * j], e = ddesc[4 * j + 2];
            for (int rr = tid; rr < BM; rr += NTHR) { const int row = pm * BM + rr;
                if (ROWS) { int tok = row - MAXSLOT; if (e < NE) { tok = stok[row]; tok = tok < 0 ? 0 : tok; } drow[j * BM + rr] = tok; }
                dscale[j * BM + rr] = (shared_one && e >= NE) ? 1.f : rowscale[row]; } }
        __syncthreads();
    }
    __device__ __forceinline__ bool next(int i, Unit& u) const {
        if (i >= nu) return false;
        u.pm = __builtin_amdgcn_readfirstlane(ddesc[4 * i]); u.pn = __builtin_amdgcn_readfirstlane(ddesc[4 * i + 1]); u.e = __builtin_amdgcn_readfirstlane(ddesc[4 * i + 2]); u.slot = i; return true;
    }
    __device__ __forceinline__ unsigned a_off(const Unit& u, int r_) const { return (unsigned)(ROWS ? drow[u.slot * BM + r_] : u.pm * BM + r_) * lda2; }
    __device__ __forceinline__ unsigned a_koff(const Unit&) const { return 0u; }
    __device__ __forceinline__ const char* b_ptr(const Unit& u) const { return Bt + (size_t)((unsigned)u.e * estride + (unsigned)u.pn * tstride); }
};
typedef MoeOrder<13, true> MoeGU; typedef MoeOrder<26, false> MoeDN;
struct EpiGateUp {
    static constexpr bool HAS_MID = false;
    bf16* __restrict__ hmid; const LAS float* srs;
    __device__ __forceinline__ void mid(Acc&, const Unit&, int, int, int, int) const {}
    __device__ __forceinline__ void operator()(const Acc& acc, const Unit& un, int wr, int wc, int fr, int fq) const {
        const int r0 = un.pm * BM + wr * 64 + fr;
        bf16* dst = hmid + (size_t)r0 * DE + 128 * un.pn + 32 * wc + 8 * fq;
#pragma unroll
        for (int ai = 0; ai < 2; ++ai) { float rs[4];
#pragma unroll
            for (int m = 0; m < 4; ++m) rs[m] = srs[un.slot * BM + wr * 64 + fr + ai * HALF + m * 16];
#pragma unroll
            for (int m = 0; m < 4; ++m) { const f32x4 g0 = acc[ai][0][m][0] * rs[m], g1 = acc[ai][0][m][1] * rs[m], u0 = acc[ai][1][m][0] * rs[m], u1 = acc[ai][1][m][1] * rs[m]; u32x4 w;
                w.x = cvt_pk_bf16(g0[0] * sigm(g0[0]) * u0[0], g0[1] * sigm(g0[1]) * u0[1]); w.y = cvt_pk_bf16(g0[2] * sigm(g0[2]) * u0[2], g0[3] * sigm(g0[3]) * u0[3]);
                w.z = cvt_pk_bf16(g1[0] * sigm(g1[0]) * u1[0], g1[1] * sigm(g1[1]) * u1[1]); w.w = cvt_pk_bf16(g1[2] * sigm(g1[2]) * u1[2], g1[3] * sigm(g1[3]) * u1[3]);
                *(u32x4*)(dst + (size_t)(ai * HALF + m * 16) * DE) = w; } }
    }
};
struct EpiDown {
    static constexpr bool HAS_MID = false;
    unsigned char* __restrict__ y; const LAS float* sw; unsigned char* __restrict__ ysh; unsigned char* __restrict__ ysc;
    __device__ __forceinline__ void mid(Acc&, const Unit&, int, int, int, int) const {}
    __device__ __forceinline__ void operator()(const Acc& acc, const Unit& un, int wr, int wc, int fr, int fq) const {
        const int r0 = un.pm * BM + wr * 64 + fr;
        unsigned char* dst = (un.e < NE ? y + (size_t)r0 * D : ysh + (size_t)(r0 - MAXSLOT) * D) + un.pn * BM + 64 * wc + 16 * fq;
        unsigned char* sc = ysc + (size_t)r0 * 16 + un.pn * 4 + wc;
#pragma unroll
        for (int ai = 0; ai < 2; ++ai) { float wt[4];
#pragma unroll
            for (int m = 0; m < 4; ++m) wt[m] = sw[un.slot * BM + wr * 64 + fr + ai * HALF + m * 16];
#pragma unroll
            for (int m = 0; m < 4; ++m) {
                f32x4 v[2][2]; float am = 0.f;
#pragma unroll
                for (int bj = 0; bj < 2; ++bj)
#pragma unroll
                    for (int n = 0; n < 2; ++n) { v[bj][n] = acc[ai][bj][m][n] * wt[m];
                        am = fmaxf(am, fmaxf(fmaxf(fabsf(v[bj][n][0]), fabsf(v[bj][n][1])), fmaxf(fabsf(v[bj][n][2]), fabsf(v[bj][n][3])))); }
                am = fmaxf(am, __shfl_xor(am, 16)); am = fmaxf(am, __shfl_xor(am, 32));
                const unsigned eb = (__float_as_uint(fmaxf(am * (1.f / 127.f), 1e-30f)) + 0x7fffffu) >> 23;
                const float inv = __uint_as_float((254u - eb) << 23);
                u32x4 w;
#pragma unroll
                for (int bj = 0; bj < 2; ++bj)
#pragma unroll
                    for (int n = 0; n < 2; ++n) { const f32x4 t = v[bj][n]; unsigned pw = 0u;
                        pw = __builtin_amdgcn_cvt_pk_u8_f32(rintf(fmaf(t[0], inv, 128.f)), 0, pw); pw = __builtin_amdgcn_cvt_pk_u8_f32(rintf(fmaf(t[1], inv, 128.f)), 1, pw);
                        pw = __builtin_amdgcn_cvt_pk_u8_f32(rintf(fmaf(t[2], inv, 128.f)), 2, pw); pw = __builtin_amdgcn_cvt_pk_u8_f32(rintf(fmaf(t[3], inv, 128.f)), 3, pw);
                        w[2 * bj + n] = pw; }
                *(u32x4*)(dst + (size_t)(ai * HALF + m * 16) * D) = w;
                if (fq == 0) sc[(size_t)(ai * HALF + m * 16) * 16] = (unsigned char)eb;
            }
        }
    }
};
}

constexpr int N_ECVT = 3 * (NE + 1) * (D / 64) * (DE / 64);
struct CvtDesc { const float* W; bf16* WT; const float* gk; int N, ldo, mode, k0, n0; };
__device__ __forceinline__ void cvt_desc(const Params& p, int it, CvtDesc& d) {
    constexpr int I_E = (D / 64) * (DE / 64);
    const int kind = it / ((NE + 1) * I_E), rr = it % ((NE + 1) * I_E), e = rr / I_E, item = rr % I_E;
    if (kind < 2) { d.W = (kind == 0 ? (e < NE ? p.w_eg + (size_t)e * D * DE : p.w_sg) : (e < NE ? p.w_eu + (size_t)e * D * DE : p.w_su)); d.WT = (bf16*)(p.ws + WS_WGU) + (size_t)e * 512 * D; d.gk = p.norm_ffn_g;
        d.N = DE; d.ldo = D; d.mode = 1 + kind; }
    else { d.W = e < NE ? p.w_ed + (size_t)e * DE * D : p.w_sd; d.WT = (bf16*)(p.ws + WS_WD) + (size_t)e * D * DE; d.gk = nullptr; d.N = D; d.ldo = DE; d.mode = 0; }
    const int nblk = d.N / 64; d.k0 = 64 * (item / nblk); d.n0 = 64 * (item % nblk);
}
__device__ __forceinline__ void cvt_load(const CvtDesc& d, f32x4 (&v)[16], int lane) {
    const int kr = lane >> 4, n4 = (lane & 15) * 4;
#pragma unroll
    for (int i = 0; i < 16; ++i) { const int kk = 2 * (kr + 4 * (i >> 1)) + (i & 1); v[i] = __builtin_nontemporal_load((const f32x4*)(d.W + (size_t)(d.k0 + kk) * d.N + d.n0 + n4)); }
}
__device__ __forceinline__ void cvt_finish(const CvtDesc& d, f32x4 (&v)[16], float* scr, int lane) {
    const int kr = lane >> 4, n4 = (lane & 15) * 4; unsigned* tl = (unsigned*)scr;
#pragma unroll
    for (int m = 0; m < 8; ++m) { const int kp = kr + 4 * m; f32x4 x0 = v[2 * m], x1 = v[2 * m + 1];
        if (d.gk) { x0 = x0 * d.gk[d.k0 + 2 * kp]; x1 = x1 * d.gk[d.k0 + 2 * kp + 1]; }
        u32x4 w; w.x = pk2(x0[0], x1[0]); w.y = pk2(x0[1], x1[1]); w.z = pk2(x0[2], x1[2]); w.w = pk2(x0[3], x1[3]);
        *(u32x4*)(tl + kp * 64 + (n4 ^ (4 * m))) = w; }
    asm volatile("s_waitcnt lgkmcnt(0)" ::: "memory");
    const int c = lane & 7;
#pragma unroll
    for (int j = 0; j < 8; ++j) { const int n = (lane >> 3) + 8 * j; const unsigned* sp = tl + (4 * c) * 64 + (n ^ (4 * c));
        u32x4 o; o.x = sp[0]; o.y = sp[64]; o.z = sp[128]; o.w = sp[192];
        const int cn = d.n0 + n; const int row = d.mode == 0 ? MapDown{}(cn) : 256 * (cn >> 7) + 128 * (d.mode - 1) + (cn & 127);
        __builtin_nontemporal_store(o, (u32x4*)(d.WT + (size_t)row * d.ldo + d.k0 + 8 * c)); }
    asm volatile("s_waitcnt lgkmcnt(0)" ::: "memory");
}
__device__ __forceinline__ void expert_cvt_loop(const Params& p, int gw, int NGW, float* scr, int lane) {
    CvtDesc da, db; f32x4 va[16], vb[16];
    int it = gw; if (it >= N_ECVT) return;
    cvt_desc(p, it, da); cvt_load(da, va, lane);
    for (;;) {
        int itn = it + NGW; const bool hb = itn < N_ECVT;
        if (hb) { cvt_desc(p, itn, db); cvt_load(db, vb, lane); }
        cvt_finish(da, va, scr, lane);
        if (!hb) break;
        it = itn; itn = it + NGW; const bool ha = itn < N_ECVT;
        if (ha) { cvt_desc(p, itn, da); cvt_load(da, va, lane); }
        cvt_finish(db, vb, scr, lane);
        if (!ha) break;
        it = itn;
    }
}

constexpr int N_LATE = 2 * (512 / 64) * (D / 64) + (D / 64) * (D / 64) + 2 * (D / 64);
__device__ __forceinline__ void late_weight_item(const Params& p, int r, float* wscr, int lane) {
    constexpr int I_CO = (512 / 64) * (D / 64), I_O = (D / 64) * (D / 64), I_R = D / 64; unsigned char* ws = p.ws;
    if (r < I_CO) { transpose_item<false>(p.w_conv_out, 512, D, (bf16*)(ws + WS_WCAT), D, 0, MapId{0}, nullptr, wscr, r, lane); return; } r -= I_CO;
    if (r < I_CO) { transpose_item<false>(p.w_attn_out, 512, D, (bf16*)(ws + WS_WCAT), D, 512, MapId{0}, nullptr, wscr, r, lane); return; } r -= I_CO;
    if (r < I_O) { transpose_item<false>(p.w_o, D, D, (bf16*)(ws + WS_WO), D, 0, MapId{0}, nullptr, wscr, r, lane); return; } r -= I_O;
    if (r < I_R) { transpose_item<false>(p.w_router, D, NE, (bf16*)(ws + WS_WRH), D, 0, MapId{0}, p.norm_ffn_g, wscr, r, lane); return; } r -= I_R;
    transpose_item<true>(p.w_router, D, NE, (bf16*)(ws + WS_WRL), D, 0, MapId{0}, p.norm_ffn_g, wscr, r, lane);
}

#define PHASE_VARS const int tid = otid(WID), lane = tid & 63, wave = owid(WID), gw = blockIdx.x * NWAVES + wave; float* wscr = (float*)(lds + wave * WSCR_BYTES); (void)lane; (void)gw; (void)wscr;
typedef const __attribute__((address_space(4))) Params* KParams;
__device__ __forceinline__ Params load_params() {
#if defined(__HIP_DEVICE_COMPILE__)
    KParams q = (KParams)__builtin_amdgcn_kernarg_segment_ptr(); asm volatile("" : "+s"(q)); Params r; __builtin_memcpy(&r, (const __attribute__((address_space(4))) void*)q, sizeof(Params)); return r;
#else
    return Params{};
#endif
}
#define PHASE_P const Params p = load_params(); unsigned char* ws = p.ws; int* ctl = (int*)(ws + WS_CTL); (void)ctl;
__global__ void __launch_bounds__(NTHR, 2) mk_fwd(Params p_arg) {
    extern __shared__ __attribute__((aligned(16))) unsigned char lds[];
    const int G = gridDim.x, NGW = G * NWAVES;
    const int WID = __builtin_amdgcn_readfirstlane(threadIdx.x >> 6);
    for (int u = otid(WID); u < (LDS_BYTES - LDS_CTL_OFF) / 4; u += NTHR) ((unsigned*)(lds + LDS_CTL_OFF))[u] = 0u;
    __syncthreads();
    XcdBarrier bar = xcd_barrier_post((unsigned*)(p_arg.ws + WS_CTL) + CW_BAR, (volatile LAS unsigned*)(lds + LDS_CTL_OFF), otid(WID) == 0);
#define xcd_barrier(b) xcd_barrier_(b, otid(WID) == 0)

    {
        PHASE_P
        PHASE_VARS
        constexpr int I_IN = (D / 64) * (DIN / 64);
        const int NIT = I_IN + (G == 256 ? 0 : N_LATE);
        for (int rep = 0; rep < REPS(10); ++rep)
        for (int it = gw; it < NIT; it += NGW) {
            if (it < I_IN) transpose_item<false>(p.w_in, D, DIN, (bf16*)(ws + WS_WIN), D, 0, MapIn{}, nullptr, wscr, it, lane);
            else late_weight_item(p, it - I_IN, wscr, lane);
        }
        for (int rep = 0; rep < REPS(11); ++rep)
        for (int m = gw; m < S; m += NGW) rmsnorm_row(p.x + (size_t)m * D, p.norm_mix_g, (bf16*)(ws + WS_H) + (size_t)m * D, lane);
    }
    xcd_barrier(bar);
    {
        PHASE_P
        const int q8 = (int)(blockIdx.x >> 3), x8 = (int)(blockIdx.x & 7); const bool split = (G == 256), streamer = split && ((q8 & 3) == 3);
        if (!streamer) {
            pg8::DenseOrder So; So.init(S, DIN, D, D, ws + WS_WIN, split ? 192 : G, split ? 8 * (q8 - (q8 >> 2)) + x8 : (int)blockIdx.x);
            pg8::EpiProj E{(bf16*)(ws + WS_U), (bf16*)(ws + WS_Q), (bf16*)(ws + WS_K), (bf16*)(ws + WS_VT), (bf16*)(ws + WS_SGA), (bf16*)(ws + WS_SGB), p.q_norm_g, p.k_norm_g};
            pg8::gemm_phase<pg8::EpiProj, pg8::DenseOrder, true>((LAS unsigned char*)lds, (const char*)(ws + WS_H), D, So, E, WID);
        } else {
            PHASE_VARS
            for (int it = (8 * (q8 >> 2) + x8) * NWAVES + wave; it < N_LATE; it += 64 * NWAVES) late_weight_item(p, it, wscr, lane);
            expert_cvt_loop(p, (8 * (q8 >> 2) + x8) * NWAVES + wave, 64 * NWAVES, wscr, lane);
        }
    }
#if PROBE == 1
    {
        PHASE_P
        pg8::DenseOrder So; So.init(S, DIN, D, D, ws + WS_WIN, G, (int)blockIdx.x);
        pg8::EpiProj E{(bf16*)(ws + WS_U), (bf16*)(ws + WS_Q), (bf16*)(ws + WS_K), (bf16*)(ws + WS_VT), (bf16*)(ws + WS_SGA), (bf16*)(ws + WS_SGB), p.q_norm_g, p.k_norm_g};
        pg8::gemm_phase<pg8::EpiProj, pg8::DenseOrder, true>((LAS unsigned char*)lds, (const char*)(ws + WS_H), D, So, E, WID);
    }
#endif
    xcd_barrier(bar);
    {
        PHASE_P
        PHASE_VARS
        const bool docvt = (G != 256), cvt_first = docvt && (((blockIdx.x >> 3) & 1) != 0);
        if (cvt_first) { for (int rep = 0; rep < REPS(22); ++rep) expert_cvt_loop(p, gw, NGW, wscr, lane); __syncthreads(); }
        conv_phase(p, lds, G, WID);
        for (int rep = 0; rep < REPS(21); ++rep) attn_phase(p, lds, G, WID);
        if (docvt && !cvt_first) { __syncthreads(); for (int rep = 0; rep < REPS(22); ++rep) expert_cvt_loop(p, gw, NGW, wscr, lane); }
    }
    xcd_barrier(bar);
    {
        PHASE_P
        pg8::DenseOrder So; So.init(S, D, D, D, ws + WS_WCAT, G, (int)blockIdx.x);
        pg8::EpiMerge E{(const bf16*)(ws + WS_SGA), (const bf16*)(ws + WS_SGB), (bf16*)(ws + WS_MRG)};
        pg8::gemm_phase<pg8::EpiMerge, pg8::DenseOrder, true>((LAS unsigned char*)lds, (const char*)(ws + WS_U2), D, So, E, WID);
    }
#if PROBE == 3
    {
        PHASE_P
        pg8::DenseOrder So; So.init(S, D, D, D, ws + WS_WCAT, G, (int)blockIdx.x);
        pg8::EpiMerge E{(const bf16*)(ws + WS_SGA), (const bf16*)(ws + WS_SGB), (bf16*)(ws + WS_MRG)};
        pg8::gemm_phase<pg8::EpiMerge, pg8::DenseOrder, true>((LAS unsigned char*)lds, (const char*)(ws + WS_U2), D, So, E, WID);
    }
#endif
    xcd_barrier(bar);
    {
        PHASE_P
        pg8::DenseOrder So; So.init(S, D, D, D, ws + WS_WO, G, (int)blockIdx.x);
        pg8::EpiResid E{p.x, p.out, (bf16*)(ws + WS_H)};
        pg8::gemm_phase<pg8::EpiResid, pg8::DenseOrder, true>((LAS unsigned char*)lds, (const char*)(ws + WS_MRG), D, So, E, WID);
    }
#if PROBE == 4
    {
        PHASE_P
        pg8::DenseOrder So; So.init(S, D, D, D, ws + WS_WO, G, (int)blockIdx.x);
        pg8::EpiResid E{p.x, p.out, (bf16*)(ws + WS_H)};
        pg8::gemm_phase<pg8::EpiResid, pg8::DenseOrder, true>((LAS unsigned char*)lds, (const char*)(ws + WS_MRG), D, So, E, WID);
    }
#endif
    xcd_barrier(bar);
    {
        PHASE_P
        PHASE_VARS
        constexpr int RST = 528, PART = 64 * RST, BUF = 2 * PART;
        const bf16* wrh = (const bf16*)(ws + WS_WRH); const bf16* wrl = (const bf16*)(ws + WS_WRL); float* srs = (float*)(ws + WS_SRS);
        int* hist = (int*)(lds + LDS_CTL_OFF + 256); float* lgs = (float*)lds;
        const int g = lane >> 4, li = lane & 15, tt = wave >> 1, nh = wave & 1;
        for (int rep = 0; rep < REPS(50); ++rep)
        for (int blk = blockIdx.x; blk < S / 64; blk += G) {
            if (tid < NE) hist[tid] = 0;
            u32x4 st[8];
            const unsigned goff = (unsigned)(((tid >> 5) * D + (tid & 31) * 8) * 2), loff = (unsigned)((tid >> 5) * RST + (tid & 31) * 16);
#define R_LOAD(c) do { _Pragma("unroll") for (int j = 0; j < 8; ++j) { const char* ub = (const char*)((j >> 2) ? wrl : wrh) + (size_t)(16 * (j & 3)) * D * 2 + (c) * 512; \
                st[j] = *(const u32x4*)(ub + goff); } } while (0)
#define R_WRITE(b) do { _Pragma("unroll") for (int j = 0; j < 8; ++j) *(u32x4*)(lds + (b) * BUF + (j >> 2) * PART + 16 * (j & 3) * RST + loff) = st[j]; } while (0)
            const float* xr = p.out + (size_t)(blk * 64 + tt * 16 + li) * D + 8 * g;
            f32x4 acc[2]; float ssq = 0.f;
            for (int rep2 = 0; rep2 < REPS(51); ++rep2) {
            R_LOAD(0); R_WRITE(0); __syncthreads();
            ssq = 0.f; acc[0] = (f32x4){0.f, 0.f, 0.f, 0.f}; acc[1] = acc[0];
            f32x4 xv[8][2];
#pragma unroll
            for (int s8 = 0; s8 < 8; ++s8) { xv[s8][0] = *(const f32x4*)(xr + 32 * s8); xv[s8][1] = *(const f32x4*)(xr + 32 * s8 + 4); }
#pragma unroll 1
            for (int c = 0; c < 4; ++c) {
                if (c < 3) R_LOAD(c + 1);
                const unsigned char* bb = lds + (c & 1) * BUF + (32 * nh + li) * RST + 16 * g;
#pragma unroll
                for (int hf = 0; hf < 2; ++hf) {
#pragma unroll
                    for (int s4 = 0; s4 < 4; ++s4) { const int s8 = 4 * hf + s4;
                        const f32x4 x0 = xv[s8][0], x1 = xv[s8][1];
                        ssq += (x0[0] * x0[0] + x0[1] * x0[1]) + (x0[2] * x0[2] + x0[3] * x0[3]) + (x1[0] * x1[0] + x1[1] * x1[1]) + (x1[2] * x1[2] + x1[3] * x1[3]);
                        union { bf16x8 v; unsigned w[4]; } ah, al;
                        ah.w[0] = pk2(x0[0], x0[1]); ah.w[1] = pk2(x0[2], x0[3]); ah.w[2] = pk2(x1[0], x1[1]); ah.w[3] = pk2(x1[2], x1[3]);
                        al.w[0] = pk2(x0[0] - bf2f(ah.w[0] & 0xffff), x0[1] - bf2f(ah.w[0] >> 16)); al.w[1] = pk2(x0[2] - bf2f(ah.w[1] & 0xffff), x0[3] - bf2f(ah.w[1] >> 16));
                        al.w[2] = pk2(x1[0] - bf2f(ah.w[2] & 0xffff), x1[1] - bf2f(ah.w[2] >> 16)); al.w[3] = pk2(x1[2] - bf2f(ah.w[3] & 0xffff), x1[3] - bf2f(ah.w[3] >> 16));
#pragma unroll
                        for (int n2 = 0; n2 < 2; ++n2) { const bf16x8 wh = *(const bf16x8*)(bb + n2 * 16 * RST + 64 * s8), wl = *(const bf16x8*)(bb + PART + n2 * 16 * RST + 64 * s8);
                            acc[n2] = __builtin_amdgcn_mfma_f32_16x16x32_bf16(wh, ah.v, acc[n2], 0, 0, 0);
                            acc[n2] = __builtin_amdgcn_mfma_f32_16x16x32_bf16(wh, al.v, acc[n2], 0, 0, 0);
                            acc[n2] = __builtin_amdgcn_mfma_f32_16x16x32_bf16(wl, ah.v, acc[n2], 0, 0, 0); } }
                    if (c < 3) {
#pragma unroll
                        for (int s4 = 0; s4 < 4; ++s4) { const int s8 = 4 * hf + s4; xv[s8][0] = *(const f32x4*)(xr + (c + 1) * 256 + 32 * s8); xv[s8][1] = *(const f32x4*)(xr + (c + 1) * 256 + 32 * s8 + 4); } }
                }
                if (c < 3) R_WRITE((c + 1) & 1);
                __syncthreads();
            }
            }
#undef R_LOAD
#undef R_WRITE
            ssq += __shfl_xor(ssq, 16); ssq += __shfl_xor(ssq, 32);
            const float rs = rsqrtf(ssq * (1.f / D) + EPS);
            if (g == 0 && nh == 0) srs[MAXSLOT + blk * 64 + tt * 16 + li] = rs;
#pragma unroll
            for (int n2 = 0; n2 < 2; ++n2)
#pragma unroll
                for (int r = 0; r < 4; ++r) lgs[(tt * 16 + li) * 65 + 32 * nh + 16 * n2 + 4 * g + r] = acc[n2][r] * rs;
            __syncthreads();
            for (int rep3 = 0; rep3 < REPS(52); ++rep3)
            {   int* hh = hist + (rep3 ? 64 : 0);
                float* gsh = (float*)(lds + 49152); float* wsel = (float*)(lds + 32768);
                const int tok = tid >> 3, j = tid & 7, t = blk * 64 + tok;
                float sc[8], b[8];
#pragma unroll
                for (int i = 0; i < 8; ++i) { sc[i] = sigmoidf_(lgs[tok * 65 + 8 * j + i]); b[i] = sc[i] + p.router_bias[8 * j + i]; }
                { float m1 = -3.0e38f, m2 = -3.0e38f;
#pragma unroll
                  for (int i = 0; i < 8; ++i) { const float v = b[i]; if (v > m1) { m2 = m1; m1 = v; } else if (v > m2) m2 = v; }
                  gsh[tok * 8 + j] = m1 + m2; }
                asm volatile("s_waitcnt lgkmcnt(0)" ::: "memory");
                bool mine;
                { const f32x4 ga = *(const f32x4*)(gsh + tok * 8), gb = *(const f32x4*)(gsh + tok * 8 + 4);
                  const float gq[8] = {ga[0], ga[1], ga[2], ga[3], gb[0], gb[1], gb[2], gb[3]}; const float gme = (j == 0 ? gq[0] : j == 1 ? gq[1] : j == 2 ? gq[2] : j == 3 ? gq[3] : j == 4 ? gq[4] : j == 5 ? gq[5] : j == 6 ? gq[6] : gq[7]);
                  int r = 0;
#pragma unroll
                  for (int q = 0; q < 8; ++q) r += (gq[q] > gme || (gq[q] == gme && q < j)) ? 1 : 0;
                  mine = r < TOPG; }
                unsigned taken = mine ? 0u : 0xffu; float wpart = 0.f;
                int* tidx = (int*)(ws + WS_TIDX) + t * 8;
#define DPPF(x, ctrl) __uint_as_float((unsigned)__builtin_amdgcn_update_dpp(0, (int)__float_as_uint(x), ctrl, 0xf, 0xf, true))
#define DPPI(x, ctrl) __builtin_amdgcn_update_dpp(0, x, ctrl, 0xf, 0xf, true)
#pragma unroll 1
                for (int kq = 0; kq < TOPK; ++kq) {
                    float bv = -3.0e38f, bs = 0.f; int bi = 64;
#pragma unroll
                    for (int i = 0; i < 8; ++i) { const bool ok = !((taken >> i) & 1u) && b[i] > bv; bv = ok ? b[i] : bv; bs = ok ? sc[i] : bs; bi = ok ? 8 * j + i : bi; }
                    float mv = bv; int mi = bi;
#pragma unroll
                    for (int st = 0; st < 3; ++st) { const int ctrl = st == 0 ? 0xB1 : (st == 1 ? 0x4E : 0x141);
                        const float ov = st == 0 ? DPPF(mv, 0xB1) : (st == 1 ? DPPF(mv, 0x4E) : DPPF(mv, 0x141)); const int oi = st == 0 ? DPPI(mi, 0xB1) : (st == 1 ? DPPI(mi, 0x4E) : DPPI(mi, 0x141)); (void)ctrl;
                        const bool tk = ov > mv || (ov == mv && oi < mi); mv = tk ? ov : mv; mi = tk ? oi : mi; }
                    if (mi == bi && bi < 64) { taken |= 1u << (bi & 7); wpart += bs; tidx[kq] = bi; wsel[tok * 8 + kq] = bs; atomicAdd(hh + bi, 1); }
                }
#undef DPPF
#undef DPPI
                float wsum = wpart; wsum += __shfl_xor(wsum, 1); wsum += __shfl_xor(wsum, 2); wsum += __shfl_xor(wsum, 4);
                asm volatile("s_waitcnt lgkmcnt(0)" ::: "memory");
                ((float*)(ws + WS_TW))[t * 8 + j] = wsel[tok * 8 + j] * (ROUTE_SCALE / wsum);
            }
            __syncthreads();
            if (tid < NE) ((int*)(ws + WS_CNTB))[blk * NE + tid] = hist[tid];
            __syncthreads();
        }
    }
    xcd_barrier(bar);
    {
        PHASE_P
        PHASE_VARS
        int* s_part = (int*)lds; int* s_pre = s_part + 512; int* s_tot = s_pre + 512; int* s_base = s_tot + 64; int* s_pad = s_base + 64; int* s_start = s_pad + 64; int* s_cur = s_start + 80;
        const int* cntb = (const int*)(ws + WS_CNTB);
        int* stok = (int*)(ws + WS_STOK); float* sw = (float*)(ws + WS_SW); int* tslot = (int*)(ws + WS_TSLOT); float* srs = (float*)(ws + WS_SRS);
        const int* tidx = (const int*)(ws + WS_TIDX); const float* tw = (const float*)(ws + WS_TW);
        for (int rep = 0; rep < REPS(60); ++rep)
        for (int blk = blockIdx.x; blk < S / 64; blk += G) {
            { const int e = tid & 63, part = tid >> 6; int a = 0, b = 0;
              for (int w = 32 * part; w < 32 * part + 32; ++w) { const int v = cntb[w * NE + e]; a += v; b += (w < blk) ? v : 0; }
              s_part[tid] = a; s_pre[tid] = b; }
            __syncthreads();
            if (tid < NE) { int a = 0, b = 0;
#pragma unroll
                for (int q = 0; q < 8; ++q) { a += s_part[q * 64 + tid]; b += s_pre[q * 64 + tid]; }
                s_tot[tid] = a; s_base[tid] = b; s_pad[tid] = (a + 255) >> 8; s_cur[tid] = 0; }
            __syncthreads();
            if (tid < NE) {
                const int v = s_pad[tid]; int inc = v;
#pragma unroll
                for (int o = 1; o < 64; o <<= 1) { const int t = __shfl_up(inc, o); if (lane >= o) inc += t; }
                s_start[tid] = (inc - v) * 256; if (tid == NE - 1) s_start[NE] = inc * 256; }
            __syncthreads();
            if (blk == 0) {
                if (tid < NE) { const int st = s_start[tid] >> 8; for (int j = 0; j < s_pad[tid]; ++j) ctl[C_TEXP + st + j] = tid; }
                if (tid == 0) ctl[C_NT] = s_start[NE] >> 8;
                int* eg = s_cur + 64;
                if (tid < NE) { int rank = 0; for (int e = 0; e < NE; ++e) rank += (s_pad[e] > s_pad[tid] || (s_pad[e] == s_pad[tid] && e < tid)) ? 1 : 0; eg[tid] = ((rank >> 3) & 1) ? 7 - (rank & 7) : (rank & 7); }
                __syncthreads();
                if (tid < NE) { const int x = eg[tid]; int off = 0, tot = 0;
                    for (int e = 0; e < NE; ++e) { const int pe = (eg[e] == x) ? s_pad[e] : 0; tot += pe; off += (e < tid) ? pe : 0; }
                    const int st = s_start[tid] >> 8; for (int j = 0; j < s_pad[tid]; ++j) ctl[C_XL + x * MAXT + off + j] = (st + j) | (tid << 16);
                    ctl[C_XN + x] = tot; }
            }
            if (blk < NE) { const int e = blk; const int lo = s_start[e] + s_tot[e], hi = s_start[e + 1]; for (int sl = lo + tid; sl < hi; sl += NTHR) { stok[sl] = -1; sw[sl] = 0.f; srs[sl] = 0.f; } }
            { const int i = blk * 512 + tid; const int e = tidx[i]; const int pos = atomicAdd(s_cur + e, 1); const int slot = s_start[e] + s_base[e] + pos;
              stok[slot] = i >> 3; sw[slot] = tw[i]; tslot[i] = slot; srs[slot] = srs[MAXSLOT + (i >> 3)]; }
            __syncthreads();
        }
    }
    xcd_barrier(bar);
    {
        PHASE_P
        pg8::MoeGU So; So.init(G, (int)blockIdx.x, ctl, 2, 0, 2, (const int*)(ws + WS_STOK), (const float*)(ws + WS_SRS), false, (unsigned)D * 2u, ws + WS_WGU, (unsigned)D * 2u, 512, (LAS unsigned char*)lds + AUX_OFF, WID);
        pg8::EpiGateUp E{(bf16*)(ws + WS_HMID), So.dscale};
        pg8::gemm_phase<pg8::EpiGateUp, pg8::MoeGU, true>((LAS unsigned char*)lds, (const char*)(ws + WS_H), D, So, E, WID);
    }
#if PROBE == 7
    {
        PHASE_P
        pg8::MoeGU So; So.init(G, (int)blockIdx.x, ctl, 2, 0, 2, (const int*)(ws + WS_STOK), (const float*)(ws + WS_SRS), false, (unsigned)D * 2u, ws + WS_WGU, (unsigned)D * 2u, 512, (LAS unsigned char*)lds + AUX_OFF, WID);
        pg8::EpiGateUp E{(bf16*)(ws + WS_HMID), So.dscale};
        pg8::gemm_phase<pg8::EpiGateUp, pg8::MoeGU, true>((LAS unsigned char*)lds, (const char*)(ws + WS_H), D, So, E, WID);
    }
#endif
    xcd_barrier(bar);
    {
        PHASE_P
        pg8::MoeDN So; So.init(G, (int)blockIdx.x, ctl, 4, 0, 4, nullptr, (const float*)(ws + WS_SW), true, (unsigned)DE * 2u, ws + WS_WD, (unsigned)DE * 2u, 1024, (LAS unsigned char*)lds + AUX_OFF, WID);
        pg8::EpiDown E{(unsigned char*)(ws + WS_Y), So.dscale, (unsigned char*)(ws + WS_YSH), (unsigned char*)(ws + WS_YSC)};
        pg8::gemm_phase<pg8::EpiDown, pg8::MoeDN, true>((LAS unsigned char*)lds, (const char*)(ws + WS_HMID), DE, So, E, WID);
    }
#if PROBE == 8
    {
        PHASE_P
        pg8::MoeDN So; So.init(G, (int)blockIdx.x, ctl, 4, 0, 4, nullptr, (const float*)(ws + WS_SW), true, (unsigned)DE * 2u, ws + WS_WD, (unsigned)DE * 2u, 1024, (LAS unsigned char*)lds + AUX_OFF, WID);
        pg8::EpiDown E{(unsigned char*)(ws + WS_Y), So.dscale, (unsigned char*)(ws + WS_YSH), (unsigned char*)(ws + WS_YSC)};
        pg8::gemm_phase<pg8::EpiDown, pg8::MoeDN, true>((LAS unsigned char*)lds, (const char*)(ws + WS_HMID), DE, So, E, WID);
    }
#endif
    xcd_barrier(bar);
    {
        PHASE_P
        PHASE_VARS
        const int* tslot = (const int*)(ws + WS_TSLOT); const unsigned char* y = (const unsigned char*)(ws + WS_Y); const unsigned char* ysh = (const unsigned char*)(ws + WS_YSH); const unsigned char* ysc = (const unsigned char*)(ws + WS_YSC);
        for (int rep = 0; rep < REPS(9); ++rep) {
        const float ys = rep == 0 ? 1.f : 0.f;
        for (int t = gw; t < S; t += NGW) {
            const int* ts = tslot + t * 8; float* o = p.out + (size_t)t * D + 16 * lane;
            u32x4 v[TOPK + 1]; float sc[TOPK + 1];
#pragma unroll
            for (int kq = 0; kq < TOPK; ++kq) { const int sl = ts[kq]; v[kq] = __builtin_nontemporal_load((const u32x4*)(y + (size_t)sl * D + 16 * lane)); sc[kq] = __uint_as_float((unsigned)ysc[(size_t)sl * 16 + (lane >> 2)] << 23); }
            v[TOPK] = __builtin_nontemporal_load((const u32x4*)(ysh + (size_t)t * D + 16 * lane)); sc[TOPK] = __uint_as_float((unsigned)ysc[(size_t)(MAXSLOT + t) * 16 + (lane >> 2)] << 23);
            f32x4 a[4]; float ssum = 0.f;
#pragma unroll
            for (int j = 0; j < 4; ++j) a[j] = *(const f32x4*)(o + 4 * j);
#pragma unroll
            for (int kq = 0; kq < TOPK + 1; ++kq) { const float sk = sc[kq] * ys; ssum += sk;
#pragma unroll
                for (int j = 0; j < 4; ++j) { const unsigned w = v[kq][j];
                    a[j][0] += sk * (float)(w & 0xffu); a[j][1] += sk * (float)((w >> 8) & 0xffu); a[j][2] += sk * (float)((w >> 16) & 0xffu); a[j][3] += sk * (float)(w >> 24); } }
            { const float off = 128.f * ssum;
#pragma unroll
              for (int j = 0; j < 4; ++j) a[j] = a[j] - off; }
#pragma unroll
            for (int j = 0; j < 4; ++j) *(f32x4*)(o + 4 * j) = a[j];
        }
        if (PROBE == 9 && rep == 0) { asm volatile("s_waitcnt vmcnt(0)" ::: "memory"); __syncthreads(); }
        }
    }
}

extern "C" void kernel_launch(void* const* d_in, const int* in_sizes, int n_in, void* d_out, int out_size, void* d_ws, size_t ws_size, hipStream_t stream) {
    static int grid = 0;
    if (grid == 0) {
        int dev = 0, cus = 0, per_cu = 0;
        (void)hipGetDevice(&dev); (void)hipDeviceGetAttribute(&cus, hipDeviceAttributeMultiprocessorCount, dev);
        (void)hipFuncSetAttribute((const void*)mk_fwd, hipFuncAttributeMaxDynamicSharedMemorySize, LDS_BYTES);
        (void)hipOccupancyMaxActiveBlocksPerMultiprocessor(&per_cu, (const void*)mk_fwd, NTHR, LDS_BYTES);
        (void)hipGetLastError();
        grid = cus > 0 ? cus : 256;
    }
    Params p{};
    const float** pp = (const float**)&p;
    for (int i = 0; i < 22; ++i) pp[i] = (const float*)d_in[i];
    p.out = (float*)d_out; p.ws = (unsigned char*)d_ws;
    (void)hipMemsetAsync((char*)d_ws + WS_CTL, 0, CTL_BYTES, stream);
    hipLaunchKernelGGL(mk_fwd, dim3(grid), dim3(NTHR), LDS_BYTES, stream, p);
}
```

```cpp
#include <hip/hip_runtime.h>
#include <stdint.h>

#ifndef PROBE
#define PROBE 0
#endif
#define REPS(k) ((PROBE == (k)) ? 2 : 1)
#define LAS __attribute__((address_space(3)))
typedef unsigned short bf16;
typedef short bf16x8 __attribute__((ext_vector_type(8)));
typedef float f32x4 __attribute__((ext_vector_type(4)));
typedef unsigned u32x2 __attribute__((ext_vector_type(2)));
typedef unsigned u32x4 __attribute__((ext_vector_type(4)));

constexpr int S = 16384, D = 1024, DIN = 4608, DC = 512, NH = 8, HD = 64, GW = 64, ROWS = 256;
constexpr int NE = 64, TOPK = 8, NG = 8, TOPG = 4, DE = 256;
constexpr float EPS = 1e-6f, ROUTE_SCALE = 2.5f;
constexpr int MAXT = 576;
constexpr int MAXSLOT = MAXT * 256;
constexpr int NTHR = 512, NWAVES = 8;
constexpr float WGU_SC = 64.f, WD_SC = 32.f;

constexpr size_t MiB = 1u << 20;
constexpr size_t WS_CTL = 0;
constexpr size_t CTL_BYTES = 65536;
constexpr size_t WS_WIN = 1 * MiB;
constexpr size_t WS_WCAT = 10 * MiB;
constexpr size_t WS_WO = 12 * MiB;
constexpr size_t WS_WRH = 14 * MiB;
constexpr size_t WS_WRL = 14 * MiB + 256 * 1024;
constexpr size_t WS_H = 16 * MiB;
constexpr size_t WS_U2 = 16 * MiB;
constexpr size_t WS_AO = 16 * MiB;
constexpr size_t WS_K = 48 * MiB;
constexpr size_t WS_VT = 64 * MiB;
constexpr size_t WS_MRG = 48 * MiB;
constexpr size_t WS_WGU = 80 * MiB;
constexpr size_t WS_SGA = 146 * MiB;
constexpr size_t WS_SGB = 178 * MiB;
constexpr size_t WS_Q = 210 * MiB;
constexpr size_t WS_HMID = 146 * MiB;
constexpr size_t WS_TIDX = 226 * MiB;
constexpr size_t WS_TW = 227 * MiB;
constexpr size_t WS_STOK = 228 * MiB;
constexpr size_t WS_SW = 229 * MiB;
constexpr size_t WS_TSLOT = 230 * MiB;
constexpr size_t WS_SRS = 231 * MiB;
constexpr size_t WS_CNTB = 232 * MiB;
constexpr size_t WS_WD = 236 * MiB;
constexpr size_t WS_U = 269 * MiB;
constexpr size_t WS_Y = 1 * MiB;
constexpr size_t WS_YSH = 269 * MiB;
constexpr size_t WS_YSC = 233 * MiB;
constexpr size_t WS_END = 285 * MiB;

constexpr int C_XN = 8000, C_XL = 8192;
constexpr int C_CUR2 = 3000; constexpr int C_CNT = 0, C_CUR = 64, C_PADSTART = 128, C_NT = 200, C_TEXP = 256, CW_BAR = 4096;
constexpr int LDS_BYTES = 163840, LDS_CTL_OFF = 159744, WSCR_BYTES = 17408;
constexpr int AUX_OFF = 131072;

struct Params {
    const float *x, *norm_mix_g, *w_in, *q_norm_g, *k_norm_g, *rpb, *conv_w, *conv_b, *ln_g, *ln_b, *w_conv_out, *w_attn_out, *w_o,
        *norm_ffn_g, *w_router, *router_bias, *w_eg, *w_eu, *w_ed, *w_sg, *w_su, *w_sd;
    float* out; unsigned char* ws;
};

__device__ __forceinline__ unsigned f2bf(float f) { unsigned u = __float_as_uint(f); return (u + 0x7fffu + ((u >> 16) & 1u)) >> 16; }
__device__ __forceinline__ float bf2f(unsigned h) { return __uint_as_float(h << 16); }
typedef __bf16 bf16x2_t __attribute__((ext_vector_type(2)));
typedef float f32x2_t __attribute__((ext_vector_type(2)));
__device__ __forceinline__ unsigned pk2(float lo, float hi) { f32x2_t f = {lo, hi}; bf16x2_t b = __builtin_convertvector(f, bf16x2_t); return __builtin_bit_cast(unsigned, b); }
typedef int i32x4_t __attribute__((ext_vector_type(4)));
typedef int i32x8_t __attribute__((ext_vector_type(8)));
__device__ __forceinline__ unsigned pk4f8(float a, float b, float c, float d) { int w = 0; w = __builtin_amdgcn_cvt_pk_fp8_f32(a, b, w, false); w = __builtin_amdgcn_cvt_pk_fp8_f32(c, d, w, true); return (unsigned)w; }
__device__ __forceinline__ float cl8(float v) { return __builtin_amdgcn_fmed3f(v, -448.f, 448.f); }
__device__ __forceinline__ unsigned pk4f8c(float a, float b, float c, float d) { return pk4f8(cl8(a), cl8(b), cl8(c), cl8(d)); }
__device__ __forceinline__ float sigmoidf_(float v) { return 1.f / (1.f + __expf(-v)); }
__device__ __forceinline__ int ldc(const int* p) { return __hip_atomic_load(p, __ATOMIC_RELAXED, __HIP_MEMORY_SCOPE_AGENT); }
__device__ __forceinline__ float wave_sum(float v) {
#define WS_DPP(x, ctrl) __uint_as_float((unsigned)__builtin_amdgcn_update_dpp(0, (int)__float_as_uint(x), ctrl, 0xf, 0xf, true))
    v += WS_DPP(v, 0xB1); v += WS_DPP(v, 0x4E); v += WS_DPP(v, 0x141); v += WS_DPP(v, 0x140);
#undef WS_DPP
    const int iv = (int)__float_as_uint(v);
    const float r0 = __uint_as_float((unsigned)__builtin_amdgcn_readlane(iv, 0)), r1 = __uint_as_float((unsigned)__builtin_amdgcn_readlane(iv, 16)),
                r2 = __uint_as_float((unsigned)__builtin_amdgcn_readlane(iv, 32)), r3 = __uint_as_float((unsigned)__builtin_amdgcn_readlane(iv, 48));
    return (r0 + r1) + (r2 + r3);
}

#define XB_TMO      128
#define XB_XCNT(j)  (256  + 64 * (j))
#define XB_XSUB(j)  (1280 + 64 * (j))
#define XB_XGEN(j)  (2304 + 64 * (j))
#define XB_TOP      3328
#define XB_TOPGEN   3392
#define XCD_BAR_WORDS 3456
#define XB_SPIN_CAP (1u << 18)
__device__ __forceinline__ unsigned xb_ld(unsigned* p)              { return __hip_atomic_load(p, __ATOMIC_RELAXED, __HIP_MEMORY_SCOPE_AGENT); }
__device__ __forceinline__ unsigned xb_add(unsigned* p, unsigned v) { return __hip_atomic_fetch_add(p, v, __ATOMIC_RELAXED, __HIP_MEMORY_SCOPE_AGENT); }
__device__ __forceinline__ unsigned xb_xcc_id() { return (unsigned)__builtin_amdgcn_s_getreg((3 << 11) | 20) & 0xFu; }
#define XB_SPIN(cond, bar) do { unsigned _sp = 0; while (cond) { __builtin_amdgcn_s_sleep(1); \
    if ((++_sp & 255u) == 0u) { if (xb_ld(&(bar)[XB_TMO])) break; if (_sp > XB_SPIN_CAP) { atomicAdd(&(bar)[XB_TMO], 1u); break; } } } } while (0)
struct XcdBarrier { unsigned* bar; unsigned x; volatile LAS unsigned* st; };
__device__ __forceinline__ XcdBarrier xcd_barrier_post(unsigned* bar, volatile LAS unsigned* st, bool leader) {
    XcdBarrier b; b.bar = bar; b.x = xb_xcc_id(); b.st = st;
    if (leader) (void)xb_add(&bar[XB_XCNT(b.x)], 1u);
    return b;
}
__device__ __forceinline__ void xcd_barrier_complete(unsigned* bar, unsigned x, unsigned& nloc, unsigned& nx) {
    const unsigned G = gridDim.x * gridDim.y * gridDim.z;
    unsigned sum, cnt, mine, sp = 0u;
    for (;;) {
        sum = 0u; cnt = 0u; mine = 0u;
#pragma unroll
        for (unsigned j = 0; j < 16; ++j) { const unsigned c = xb_ld(&bar[XB_XCNT(j)]); sum += c; cnt += (c > 0u) ? 1u : 0u; mine = (j == x) ? c : mine; }
        if (sum == G) break;
        __builtin_amdgcn_s_sleep(1);
        if ((++sp & 255u) == 0u) { if (xb_ld(&bar[XB_TMO])) break; if (sp > XB_SPIN_CAP) { atomicAdd(&bar[XB_TMO], 1u); break; } }
    }
    nloc = mine > 0u ? mine : 1u; nx = cnt > 0u ? cnt : 1u;
}
__device__ __forceinline__ void xcd_barrier1(const XcdBarrier& b, bool leader) {
    asm volatile("s_waitcnt vmcnt(0)" ::: "memory");
    __syncthreads();
    if (leader) {
        unsigned* bar = b.bar;
        __builtin_amdgcn_s_waitcnt(0);
        unsigned nloc = b.st[0], nx = b.st[1];
        if (nloc == 0u) { xcd_barrier_complete(bar, b.x, nloc, nx); b.st[0] = nloc; b.st[1] = nx; }
        const unsigned old = xb_add(&bar[XB_XSUB(b.x)], 1u);
        const unsigned gen = old / nloc;
        if (old + 1u == (gen + 1u) * nloc) {
            __builtin_amdgcn_fence(__ATOMIC_RELEASE, "agent");
            asm volatile("s_waitcnt vmcnt(0)" ::: "memory");
            const unsigned og = xb_add(&bar[XB_TOP], 1u);
            const unsigned tg = og / nx;
            if (og + 1u == (tg + 1u) * nx) xb_add(&bar[XB_TOPGEN], 1u);
            else XB_SPIN(xb_ld(&bar[XB_TOPGEN]) == tg, bar);
            __builtin_amdgcn_fence(__ATOMIC_ACQUIRE, "agent");
            xb_add(&bar[XB_XGEN(b.x)], 1u);
            asm volatile("s_waitcnt vmcnt(0)" ::: "memory");
        } else {
            XB_SPIN(xb_ld(&bar[XB_XGEN(b.x)]) == gen, bar);
            __builtin_amdgcn_fence(__ATOMIC_ACQUIRE, "agent");
            asm volatile("s_waitcnt vmcnt(0)" ::: "memory");
        }
    }
    __syncthreads();
}

__device__ __forceinline__ void xcd_barrier_(const XcdBarrier& b, bool leader) { xcd_barrier1(b, leader); if (PROBE == 99) xcd_barrier1(b, leader); }
__device__ __forceinline__ int owid(int WID) { int w = WID; asm volatile("" : "+s"(w)); return w; }
__device__ __forceinline__ int otid(int WID) { int l; asm volatile("v_mbcnt_lo_u32_b32 %0, -1, 0\n\tv_mbcnt_hi_u32_b32 %0, -1, %0" : "=v"(l)); return owid(WID) * 64 + l; }
struct MapId { int off; __device__ __forceinline__ int operator()(int n) const { return off + n; } };
struct MapIn {
    __device__ __forceinline__ int operator()(int n) const {
        if (n < 512) return 256 * (n >> 7) + (n & 127);
        if (n < 1024) { const int c = n - 512; return 256 * (c >> 7) + 128 + (c & 127); }
        if (n < 2048) { const int base = n < 1536 ? 1024 : 1536, c = n - base, h = c >> 6, d = c & 63; return base + 256 * (h >> 2) + (d >> 5) * 128 + 32 * (h & 3) + (d & 31); }
        return n; } };
struct MapDown { __device__ __forceinline__ int operator()(int c) const { const int o = c & 255; return (c & ~255) + 128 * ((o >> 3) & 1) + 32 * (o >> 6) + 8 * ((o >> 4) & 3) + (o & 7); } };
struct MapGU { int up; __device__ __forceinline__ int operator()(int c) const { return 256 * (c >> 7) + 128 * up + (c & 127); } };
template <bool LO, bool F8 = false, class Map> __device__ __forceinline__ void transpose_item(const float* W, int K, int N, bf16* WT, int ldo, int kofs, const Map& map, const float* gk, float* scr, int item, int lane, float wsc = 1.f) {
    const int nblk = N / 64, kb = item / nblk, nb = item % nblk, k0 = 64 * kb, n0 = 64 * nb;
    const int kr = lane >> 4, n4 = (lane & 15) * 4;
#pragma unroll
    for (int i = 0; i < 16; ++i) { const int kk = kr + 4 * i; f32x4 v = __builtin_nontemporal_load((const f32x4*)(W + (size_t)(k0 + kk) * N + n0 + n4)); if (gk) v = v * gk[k0 + kk];
        *(f32x4*)(scr + kk * 64 + (n4 ^ (4 * ((kk >> 3) & 7)))) = v; }
    asm volatile("s_waitcnt lgkmcnt(0)" ::: "memory");
    const int c = lane & 7;
#pragma unroll
    for (int j = 0; j < 8; ++j) { const int n = (lane >> 3) + 8 * j; const float* sp = scr + (8 * c) * 64 + (n ^ (4 * c)); float f[8];
#pragma unroll
        for (int i = 0; i < 8; ++i) { f[i] = sp[i * 64]; if (LO) f[i] -= bf2f(pk2(f[i], 0.f) & 0xffffu); }
        if (F8) { u32x2 o; o.x = pk4f8(f[0] * wsc, f[1] * wsc, f[2] * wsc, f[3] * wsc); o.y = pk4f8(f[4] * wsc, f[5] * wsc, f[6] * wsc, f[7] * wsc);
            *(u32x2*)((unsigned char*)WT + (size_t)map(n0 + n) * ldo + kofs + k0 + 8 * c) = o; }
        else { u32x4 o; o.x = pk2(f[0], f[1]); o.y = pk2(f[2], f[3]); o.z = pk2(f[4], f[5]); o.w = pk2(f[6], f[7]);
            *(u32x4*)(WT + (size_t)map(n0 + n) * ldo + kofs + k0 + 8 * c) = o; } }
    asm volatile("s_waitcnt lgkmcnt(0)" ::: "memory");
}
template <bool F8 = false> __device__ __forceinline__ void rmsnorm_row(const float* xrow, const float* g, bf16* orow, int lane) {
    const f32x4* xr = (const f32x4*)xrow + lane; f32x4 v[4]; float s = 0.f;
#pragma unroll
    for (int j = 0; j < 4; ++j) { v[j] = __builtin_nontemporal_load(xr + 64 * j); s += (v[j].x * v[j].x + v[j].y * v[j].y) + (v[j].z * v[j].z + v[j].w * v[j].w); }
    const float rs = rsqrtf(wave_sum(s) * (1.f / D) + EPS);
    u32x2* o = (u32x2*)orow + lane; unsigned* o8 = (unsigned*)orow + lane;
#pragma unroll
    for (int j = 0; j < 4; ++j) { const f32x4 gg = ((const f32x4*)g)[lane + 64 * j];
        if (F8) o8[64 * j] = pk4f8c(v[j].x * rs * gg.x, v[j].y * rs * gg.y, v[j].z * rs * gg.z, v[j].w * rs * gg.w);
        else { u32x2 w2; w2.x = pk2(v[j].x * rs * gg.x, v[j].y * rs * gg.y); w2.y = pk2(v[j].z * rs * gg.z, v[j].w * rs * gg.w); o[64 * j] = w2; } }
}

template <class P> __device__ __forceinline__ void wave_gemm_acc(const P& p, int m0, int n0, int K, f32x4 (&acc)[4][4], int lane) {
    const int g = lane >> 4, li = lane & 15;
    const bf16* ap[4]; const bf16* bp[4];
#pragma unroll
    for (int i = 0; i < 4; ++i) { ap[i] = p.arow(m0 + 16 * i + li) + 8 * g; bp[i] = p.brow(n0 + 16 * i + li) + 8 * g; }
    for (int k0 = 0; k0 < K; k0 += 32) {
        bf16x8 a[4], b[4];
#pragma unroll
        for (int i = 0; i < 4; ++i) { a[i] = *(const bf16x8*)(ap[i] + k0); b[i] = *(const bf16x8*)(bp[i] + k0); }
#pragma unroll
        for (int i = 0; i < 4; ++i)
#pragma unroll
            for (int j = 0; j < 4; ++j) acc[i][j] = __builtin_amdgcn_mfma_f32_16x16x32_bf16(b[j], a[i], acc[i][j], 0, 0, 0);
    }
}
__device__ __forceinline__ void zero_acc(f32x4 (&acc)[4][4]) {
#pragma unroll
    for (int i = 0; i < 4; ++i)
#pragma unroll
        for (int j = 0; j < 4; ++j) acc[i][j] = (f32x4){0.f, 0.f, 0.f, 0.f};
}
struct RowMat { const bf16* a; int lda; const bf16* b; int ldb;
    __device__ __forceinline__ const bf16* arow(int m) const { return a + (size_t)m * lda; }
    __device__ __forceinline__ const bf16* brow(int n) const { return b + (size_t)n * ldb; } };

struct ProjMat { const bf16* h; const bf16* wt;
    __device__ __forceinline__ const bf16* arow(int m) const { return h + (size_t)m * D; }
    __device__ __forceinline__ const bf16* brow(int vn) const { int n = vn; if (vn < 1024) { const int i = vn >> 6, j = vn & 63; n = (j < 32) ? (32 * i + j) : (512 + 32 * i + (j - 32)); } return wt + (size_t)n * D; } };
__device__ __forceinline__ void proj_epi(const Params& p, int m0, int n0, f32x4 (&acc)[4][4], int lane) {
    bf16 *u = (bf16*)(p.ws + WS_U), *q = (bf16*)(p.ws + WS_Q), *k = (bf16*)(p.ws + WS_K), *vT = (bf16*)(p.ws + WS_VT), *sga = (bf16*)(p.ws + WS_SGA), *sgb = (bf16*)(p.ws + WS_SGB);
    const int g = lane >> 4, li = lane & 15, vt = n0 >> 6;
#pragma unroll
    for (int mt = 0; mt < 4; ++mt) {
        const int m = m0 + 16 * mt + li;
        if (vt < 16) {
#pragma unroll
            for (int nt = 0; nt < 2; ++nt) { f32x4 a = acc[mt][nt], gt = acc[mt][nt + 2]; u32x2 w;
                w.x = pk2(a.x * sigmoidf_(gt.x), a.y * sigmoidf_(gt.y)); w.y = pk2(a.z * sigmoidf_(gt.z), a.w * sigmoidf_(gt.w));
                *(u32x2*)(u + (size_t)m * DC + 32 * vt + 16 * nt + 4 * g) = w; }
        } else if (vt < 32) {
            const bool isq = vt < 24; const int hh = isq ? vt - 16 : vt - 24; float ss = 0.f;
#pragma unroll
            for (int nt = 0; nt < 4; ++nt) { f32x4 v = acc[mt][nt]; ss += (v.x * v.x + v.y * v.y) + (v.z * v.z + v.w * v.w); }
            ss += __shfl_xor(ss, 16); ss += __shfl_xor(ss, 32);
            const float rs = rsqrtf(ss * (1.f / 64.f) + EPS) * (isq ? 0.125f : 1.f);
            const float* gg = isq ? p.q_norm_g : p.k_norm_g; bf16* o = (isq ? q : k) + (size_t)m * 512 + hh * 64;
#pragma unroll
            for (int nt = 0; nt < 4; ++nt) { f32x4 v = acc[mt][nt]; const f32x4 gv = *(const f32x4*)(gg + 16 * nt + 4 * g); u32x2 w;
                w.x = pk2(v.x * rs * gv.x, v.y * rs * gv.y); w.y = pk2(v.z * rs * gv.z, v.w * rs * gv.w); *(u32x2*)(o + 16 * nt + 4 * g) = w; }
        } else if (vt < 40) {
            const int hh = vt - 32;
#pragma unroll
            for (int nt = 0; nt < 4; ++nt)
#pragma unroll
                for (int r = 0; r < 4; ++r) vT[(size_t)(hh * 64 + 16 * nt + 4 * g + r) * S + m] = (bf16)f2bf(acc[mt][nt][r]);
        } else {
            bf16* o = (vt < 56 ? sga + (size_t)m * D + (vt - 40) * 64 : sgb + (size_t)m * D + (vt - 56) * 64);
#pragma unroll
            for (int nt = 0; nt < 4; ++nt) { f32x4 v = acc[mt][nt]; u32x2 w; w.x = pk2(sigmoidf_(v.x), sigmoidf_(v.y)); w.y = pk2(sigmoidf_(v.z), sigmoidf_(v.w));
                *(u32x2*)(o + 16 * nt + 4 * g) = w; }
        }
    }
}

__device__ __forceinline__ void conv_phase(const Params& p, unsigned char* lds, int G, int WID) {
    const bf16* u = (const bf16*)(p.ws + WS_U); bf16* u2 = (bf16*)(p.ws + WS_U2);
    unsigned char* ut = lds; float* cv = (float*)(lds + 65536);
    const int tid = otid(WID), cp = tid & 255, half = tid >> 8, wave = tid >> 6, lane = tid & 63;
    float w0[31], w1[31];
#pragma unroll
    for (int j = 0; j < 31; ++j) { const float2 wv = *(const float2*)(p.conv_w + j * DC + 2 * cp); w0[j] = wv.x; w1[j] = wv.y; }
    const float2 bv = *(const float2*)(p.conv_b + 2 * cp);
    for (int rep = 0; rep < REPS(20); ++rep)
    for (int item = blockIdx.x; item < S / 32; item += G) {
        const int t0 = item * 32;
#pragma unroll
        for (int j = 0; j < 8; ++j) { const int pc = tid + 512 * j; if (pc < 62 * 64) { const int row = pc >> 6, c16 = pc & 63, tt = t0 - 15 + row; u32x4 v = (u32x4){0u, 0u, 0u, 0u};
            if (tt >= 0 && tt < S) v = *(const u32x4*)(u + (size_t)tt * DC + c16 * 8); *(u32x4*)(ut + row * 1024 + c16 * 16) = v; } }
        __syncthreads();
#pragma unroll 1
        for (int hp = 0; hp < 2; ++hp) {
            float a0[8], a1[8];
#pragma unroll
            for (int t = 0; t < 8; ++t) { a0[t] = bv.x; a1[t] = bv.y; }
            const unsigned char* up = ut + (half * 16 + hp * 8) * 1024 + 4 * cp;
#pragma unroll
            for (int i = 0; i < 38; ++i) { const unsigned v = *(const unsigned*)(up + i * 1024); const float x0 = bf2f(v & 0xffff), x1 = bf2f(v >> 16);
#pragma unroll
                for (int t = 0; t < 8; ++t) { const int j = i - t; if (j >= 0 && j < 31) { a0[t] += w0[j] * x0; a1[t] += w1[j] * x1; } } }
#pragma unroll
            for (int t = 0; t < 8; ++t) *(float2*)(cv + (half * 16 + hp * 8 + t) * DC + 2 * cp) = make_float2(a0[t], a1[t]);
        }
        __syncthreads();
#pragma unroll
        for (int q = 0; q < 4; ++q) {
            const int tl = wave * 4 + q; const float* row = cv + tl * DC;
            f32x4 v0 = *(const f32x4*)(row + 8 * lane), v1 = *(const f32x4*)(row + 8 * lane + 4);
            const float mean = wave_sum((v0.x + v0.y) + (v0.z + v0.w) + (v1.x + v1.y) + (v1.z + v1.w)) * (1.f / DC);
            v0 = v0 - mean; v1 = v1 - mean;
            const float var = wave_sum((v0.x * v0.x + v0.y * v0.y) + (v0.z * v0.z + v0.w * v0.w) + (v1.x * v1.x + v1.y * v1.y) + (v1.z * v1.z + v1.w * v1.w)) * (1.f / DC);
            const float rstd = rsqrtf(var + EPS);
            const f32x4 g0 = *(const f32x4*)(p.ln_g + 8 * lane), g1 = *(const f32x4*)(p.ln_g + 8 * lane + 4), b0 = *(const f32x4*)(p.ln_b + 8 * lane), b1 = *(const f32x4*)(p.ln_b + 8 * lane + 4);
            v0 = v0 * rstd * g0 + b0; v1 = v1 * rstd * g1 + b1;
            u32x4 w; w.x = pk2(v0.x * sigmoidf_(v0.x), v0.y * sigmoidf_(v0.y)); w.y = pk2(v0.z * sigmoidf_(v0.z), v0.w * sigmoidf_(v0.w));
            w.z = pk2(v1.x * sigmoidf_(v1.x), v1.y * sigmoidf_(v1.y)); w.w = pk2(v1.z * sigmoidf_(v1.z), v1.w * sigmoidf_(v1.w));
            *(u32x4*)(u2 + (size_t)(t0 + tl) * D + 8 * lane) = w;
        }
        __syncthreads();
    }
}

__device__ __forceinline__ void attn_wave(const bf16* q, const bf16* k, const bf16* vT, const float* rpb, bf16* ao, int r, int h, int qb, int lane) {
    const int g = lane >> 4, qi = lane & 15, c0 = 16 * qb, c = c0 + qi;
    int cs = c0 - 8; cs = cs < 0 ? 0 : (cs > 32 ? 32 : cs);
    int colst = c - 8; colst = colst < 0 ? 0 : (colst > 48 ? 48 : colst);
    int rs = r - 4; rs = rs < 0 ? 0 : (rs > ROWS - 8 ? ROWS - 8 : rs);
    const bf16* qp = q + (size_t)(r * 64 + c) * 512 + h * 64 + 8 * g;
    const bf16x8 bq0 = *(const bf16x8*)qp, bq1 = *(const bf16x8*)(qp + 32);
    const int kk = 8 * (qi >> 2) + (qi & 3);
    float sc[8][2][4]; float mx = -3.0e38f;
#pragma unroll
    for (int i = 0; i < 8; ++i) {
        const float* bias_row = rpb + (size_t)(h * 15 + (rs + i - r + 7)) * 31;
#pragma unroll
        for (int T = 0; T < 2; ++T) {
            const bf16* kp = k + (size_t)((rs + i) * 64 + cs + kk + 4 * T) * 512 + h * 64 + 8 * g;
            f32x4 acc = (f32x4){0.f, 0.f, 0.f, 0.f};
            acc = __builtin_amdgcn_mfma_f32_16x16x32_bf16(*(const bf16x8*)kp, bq0, acc, 0, 0, 0);
            acc = __builtin_amdgcn_mfma_f32_16x16x32_bf16(*(const bf16x8*)(kp + 32), bq1, acc, 0, 0, 0);
#pragma unroll
            for (int rr = 0; rr < 4; ++rr) {
                const int kc = cs + 8 * g + rr + 4 * T; const bool valid = (kc >= colst) && (kc < colst + 16);
                int bi = kc - c + 15; bi = bi < 0 ? 0 : (bi > 30 ? 30 : bi);
                const float s = valid ? acc[rr] + bias_row[bi] : -3.0e38f;
                sc[i][T][rr] = s; mx = fmaxf(mx, s);
            }
        }
    }
    mx = fmaxf(mx, __shfl_xor(mx, 16)); mx = fmaxf(mx, __shfl_xor(mx, 32));
    float sum = 0.f;
#pragma unroll
    for (int i = 0; i < 8; ++i)
#pragma unroll
        for (int T = 0; T < 2; ++T)
#pragma unroll
            for (int rr = 0; rr < 4; ++rr) { const float s = sc[i][T][rr]; const float e = (s > -1.0e38f) ? __expf(s - mx) : 0.f; sc[i][T][rr] = e; sum += e; }
    sum += __shfl_xor(sum, 16); sum += __shfl_xor(sum, 32);
    const float inv = 1.f / sum;
    f32x4 o[4];
#pragma unroll
    for (int n = 0; n < 4; ++n) o[n] = (f32x4){0.f, 0.f, 0.f, 0.f};
#pragma unroll
    for (int i = 0; i < 8; ++i) {
        union { bf16x8 v; unsigned w[4]; } pb;
        pb.w[0] = pk2(sc[i][0][0], sc[i][0][1]); pb.w[1] = pk2(sc[i][0][2], sc[i][0][3]); pb.w[2] = pk2(sc[i][1][0], sc[i][1][1]); pb.w[3] = pk2(sc[i][1][2], sc[i][1][3]);
#pragma unroll
        for (int n = 0; n < 4; ++n) {
            const bf16x8 av = *(const bf16x8*)(vT + (size_t)(h * 64 + 16 * n + qi) * S + (rs + i) * 64 + cs + 8 * g);
            o[n] = __builtin_amdgcn_mfma_f32_16x16x32_bf16(av, pb.v, o[n], 0, 0, 0);
        }
    }
    bf16* op = ao + (size_t)(r * 64 + c) * D + 512 + h * 64 + 4 * g;
#pragma unroll
    for (int n = 0; n < 4; ++n) { u32x2 w; w.x = pk2(o[n].x * inv, o[n].y * inv); w.y = pk2(o[n].z * inv, o[n].w * inv); *(u32x2*)(op + 16 * n) = w; }
}


__device__ __forceinline__ void attn_phase(const Params& p, unsigned char* lds, int G, int WID) {
    const bf16* q = (const bf16*)(p.ws + WS_Q); const bf16* kk_ = (const bf16*)(p.ws + WS_K); const bf16* vT = (const bf16*)(p.ws + WS_VT); bf16* ao = (bf16*)(p.ws + WS_AO);
    unsigned char* kr = lds; unsigned char* vr = lds + 65536; float* xch = (float*)(lds + 131072); float* bt = (float*)(lds + 131072 + 10240);
    const int tid = otid(WID), lane = tid & 63, wave = owid(WID), g = lane >> 4, qi = lane & 15, qb = wave & 3, kh = wave >> 2;
    const int srow = tid >> 3, sch = tid & 7;
    const int c0 = 16 * qb, c = c0 + qi;
    int cs = c0 - 8; cs = cs < 0 ? 0 : (cs > 32 ? 32 : cs);
    int colst = c - 8; colst = colst < 0 ? 0 : (colst > 48 ? 48 : colst);
    const int kcol = 8 * (qi >> 2) + (qi & 3);
    int bofs[2][4]; unsigned vmask = 0u;
#pragma unroll
    for (int T = 0; T < 2; ++T)
#pragma unroll
        for (int rr = 0; rr < 4; ++rr) { const int kc = cs + 8 * g + rr + 4 * T; if ((kc >= colst) && (kc < colst + 16)) vmask |= 1u << (4 * T + rr); int bi = kc - c + 15; bofs[T][rr] = bi < 0 ? 0 : (bi > 30 ? 30 : bi); }
    for (int unit = blockIdx.x; unit < NH * (ROWS / 8); unit += G) {
        const int h = unit & 7, r0 = (unit >> 3) * 8;
        __syncthreads();
        for (int i = tid; i < 15 * 31; i += NTHR) bt[i] = p.rpb[h * 465 + i] * 1.44269504089f;
        int rs0 = r0 - 4; rs0 = rs0 < 0 ? 0 : (rs0 > ROWS - 8 ? ROWS - 8 : rs0);
#pragma unroll
        for (int j = 0; j < 8; ++j) { const int krow = rs0 + j, sl = krow & 7;
            const u32x4 a = *(const u32x4*)(kk_ + (size_t)(krow * 64 + srow) * 512 + h * 64 + sch * 8), b = *(const u32x4*)(vT + (size_t)(h * 64 + srow) * S + krow * 64 + sch * 8);
            *(u32x4*)(kr + sl * 8192 + srow * 128 + ((sch ^ (srow & 7)) << 4)) = a; *(u32x4*)(vr + sl * 8192 + srow * 128 + ((sch ^ (srow & 7)) << 4)) = b; }
        __syncthreads();
        bf16x8 bq0, bq1;
        { const bf16* qp = q + (size_t)(r0 * 64 + c) * 512 + h * 64 + 8 * g; bq0 = *(const bf16x8*)qp; bq1 = *(const bf16x8*)(qp + 32); }
#pragma unroll 1
        for (int j = 0; j < 8; ++j) {
            const int r = r0 + j; int rs = r - 4; rs = rs < 0 ? 0 : (rs > ROWS - 8 ? ROWS - 8 : rs);
            int rsn = r + 1 - 4; rsn = rsn < 0 ? 0 : (rsn > ROWS - 8 ? ROWS - 8 : rsn);
            const bool pf = (j < 7) && (rsn != rs);
            u32x4 pa = (u32x4){0u, 0u, 0u, 0u}, pb = pa;
            if (pf) { const int krow = rsn + 7; pa = *(const u32x4*)(kk_ + (size_t)(krow * 64 + srow) * 512 + h * 64 + sch * 8); pb = *(const u32x4*)(vT + (size_t)(h * 64 + srow) * S + krow * 64 + sch * 8); }
            bf16x8 nq0 = bq0, nq1 = bq1;
            if (j < 7) { const bf16* qp = q + (size_t)((r + 1) * 64 + c) * 512 + h * 64 + 8 * g; nq0 = *(const bf16x8*)qp; nq1 = *(const bf16x8*)(qp + 32); }
            float sc[4][2][4]; float mx = -3.0e38f;
#pragma unroll
            for (int i4 = 0; i4 < 4; ++i4) {
                const int i = 4 * kh + i4, sl = (rs + i) & 7; const float* brow = bt + (rs + i - r + 7) * 31;
#pragma unroll
                for (int T = 0; T < 2; ++T) {
                    const int col = cs + kcol + 4 * T; const unsigned char* kp = kr + sl * 8192 + col * 128;
                    const bf16x8 k0 = *(const bf16x8*)(kp + (((g) ^ (col & 7)) << 4)), k1 = *(const bf16x8*)(kp + (((4 + g) ^ (col & 7)) << 4));
                    f32x4 acc = (f32x4){0.f, 0.f, 0.f, 0.f};
                    acc = __builtin_amdgcn_mfma_f32_16x16x32_bf16(k0, bq0, acc, 0, 0, 0);
                    acc = __builtin_amdgcn_mfma_f32_16x16x32_bf16(k1, bq1, acc, 0, 0, 0);
#pragma unroll
                    for (int rr = 0; rr < 4; ++rr) {
                        const float sv = ((vmask >> (4 * T + rr)) & 1u) ? acc[rr] + brow[bofs[T][rr]] : -3.0e38f;
                        sc[i4][T][rr] = sv; mx = fmaxf(mx, sv);
                    }
                }
            }
            mx = fmaxf(mx, __shfl_xor(mx, 16)); mx = fmaxf(mx, __shfl_xor(mx, 32));
            float sum = 0.f;
#pragma unroll
            for (int i4 = 0; i4 < 4; ++i4)
#pragma unroll
                for (int T = 0; T < 2; ++T)
#pragma unroll
                    for (int rr = 0; rr < 4; ++rr) { const float e = __builtin_amdgcn_exp2f(sc[i4][T][rr] - mx); sc[i4][T][rr] = e; sum += e; }
            sum += __shfl_xor(sum, 16); sum += __shfl_xor(sum, 32);
            f32x4 o[4];
#pragma unroll
            for (int n = 0; n < 4; ++n) o[n] = (f32x4){0.f, 0.f, 0.f, 0.f};
#pragma unroll
            for (int i4 = 0; i4 < 4; ++i4) {
                const int sl = (rs + 4 * kh + i4) & 7;
                union { bf16x8 v; unsigned w[4]; } pb2;
                pb2.w[0] = pk2(sc[i4][0][0], sc[i4][0][1]); pb2.w[1] = pk2(sc[i4][0][2], sc[i4][0][3]); pb2.w[2] = pk2(sc[i4][1][0], sc[i4][1][1]); pb2.w[3] = pk2(sc[i4][1][2], sc[i4][1][3]);
#pragma unroll
                for (int n = 0; n < 4; ++n) { const int d = 16 * n + qi;
                    const bf16x8 av = *(const bf16x8*)(vr + sl * 8192 + d * 128 + ((((cs >> 3) + g) ^ (d & 7)) << 4));
                    o[n] = __builtin_amdgcn_mfma_f32_16x16x32_bf16(av, pb2.v, o[n], 0, 0, 0); }
            }
            if (kh == 1) {
                float* x = xch + qb * 640 + lane; x[0] = mx; x[64] = sum;
#pragma unroll
                for (int n = 0; n < 4; ++n) { x[(2 + 2 * n) * 64] = __uint_as_float(pk2(o[n][0], o[n][1])); x[(3 + 2 * n) * 64] = __uint_as_float(pk2(o[n][2], o[n][3])); }
            }
            __syncthreads();
            if (pf) { const int sl = (rsn + 7) & 7; *(u32x4*)(kr + sl * 8192 + srow * 128 + ((sch ^ (srow & 7)) << 4)) = pa; *(u32x4*)(vr + sl * 8192 + srow * 128 + ((sch ^ (srow & 7)) << 4)) = pb; }
            if (kh == 0) {
                const float* x = xch + qb * 640 + lane; const float mB = x[0], lB = x[64];
                const float m = fmaxf(mx, mB), fa = __builtin_amdgcn_exp2f(mx - m), fb = __builtin_amdgcn_exp2f(mB - m), inv = 1.f / (sum * fa + lB * fb);
                bf16* op = ao + (size_t)(r * 64 + c) * D + 512 + h * 64 + 4 * g;
#pragma unroll
                for (int n = 0; n < 4; ++n) { const unsigned w0 = __float_as_uint(x[(2 + 2 * n) * 64]), w1 = __float_as_uint(x[(3 + 2 * n) * 64]);
                    const float v0 = (o[n][0] * fa + bf2f(w0 & 0xffff) * fb) * inv, v1 = (o[n][1] * fa + bf2f(w0 >> 16) * fb) * inv, v2 = (o[n][2] * fa + bf2f(w1 & 0xffff) * fb) * inv, v3 = (o[n][3] * fa + bf2f(w1 >> 16) * fb) * inv;
                    u32x2 w; w.x = pk2(v0, v1); w.y = pk2(v2, v3); *(u32x2*)(op + 16 * n) = w; }
            }
            __syncthreads();
            bq0 = nq0; bq1 = nq1;
        }
    }
}


namespace pg8 {
constexpr int BM = 256, BK = 64, HALF = 128, HTB = HALF * BK * 2;
__device__ __forceinline__ int lds_byte(int r, int c) { const int st = (r >> 4) * 2 + (c >> 5), rr = r & 15, cc = c & 31, ob = rr * 64 + cc * 2; return st * 1024 + (ob ^ (((ob >> 9) & 1) << 5)); }
__device__ __forceinline__ void stage_rc(int b, int& R, int& C) { const int st = b / 1024, sb = b % 1024, swz = sb ^ (((sb >> 9) & 1) << 5); R = (st >> 1) * 16 + swz / 64; C = (st & 1) * 32 + (swz % 64) / 2; }
__device__ __forceinline__ int perm32(int rho) { const int n = rho >> 4, i = rho & 15; return 8 * (i >> 2) + 4 * n + (i & 3); }
__device__ __forceinline__ unsigned cvt_pk_bf16(float lo, float hi) { return pk2(lo, hi); }
struct Unit { int pm, pn, e, slot; };
typedef f32x4 Acc[2][2][4][2];

__device__ __forceinline__ i32x8_t cat8(bf16x8 a, bf16x8 b) { return __builtin_shufflevector(__builtin_bit_cast(i32x4_t, a), __builtin_bit_cast(i32x4_t, b), 0, 1, 2, 3, 4, 5, 6, 7); }
template <class Epi, class Sched, bool ALIGN_EPI, int F8SH = -1>
__device__ __forceinline__ void gemm_phase(LAS unsigned char* lds, const char* A, int K, const Sched& S, const Epi& E, int WID) {
    constexpr bool F8 = F8SH >= 0;
    int tid_ = otid(WID);
    const int tid = tid_, wid = owid(WID), lane = tid & 63, wr = wid >> 2, wc = wid & 3, fr = lane & 15, fq = lane >> 4;
    const int nt = K / BK;
    unsigned voffB[2];
#pragma unroll
    for (int i = 0; i < 2; ++i) { int R, C; stage_rc(tid * 16 + i * 8192, R, C); const int Rb = (R & ~31) + perm32(R & 31); voffB[i] = (unsigned)(Rb * K + C) * 2u; }
#define PG8_AOFFS(un, o00, o01, o10, o11) do { int t2_ = tid; asm volatile("" : "+v"(t2_)); int R0_, C0_, R1_, C1_; stage_rc(t2_ * 16, R0_, C0_); stage_rc(t2_ * 16 + 8192, R1_, C1_); const unsigned ko_ = S.a_koff(un); \
        o00 = S.a_off(un, R0_) + ko_ + (unsigned)C0_ * 2u; o01 = S.a_off(un, R1_) + ko_ + (unsigned)C1_ * 2u; o10 = S.a_off(un, HALF + R0_) + ko_ + (unsigned)C0_ * 2u; o11 = S.a_off(un, HALF + R1_) + ko_ + (unsigned)C1_ * 2u; } while (0)
    const size_t kstep = (size_t)(BK * 2);
    const size_t hstepB = (size_t)HALF * K * 2;
    const unsigned ldsw = (unsigned)wid * 1024u;
    const int aoff = lds_byte(wr * 64 + fr, fq * 8), boff = lds_byte(wc * 32 + fr, fq * 8);
#define PG8_SA(b, h) (((b) * 2 + (h)) * HTB)
#define PG8_SB(b, h) ((4 + (b) * 2 + (h)) * HTB)
#define PG8_STAGE(bufoff, gbase, v0, v1) do { \
        __builtin_amdgcn_global_load_lds((const unsigned*)((const char*)(gbase) + (v0)), (LAS unsigned*)(lds + (bufoff) + ldsw), 16, 0, 0); \
        __builtin_amdgcn_global_load_lds((const unsigned*)((const char*)(gbase) + (v1)), (LAS unsigned*)(lds + (bufoff) + ldsw + 8192), 16, 0, 0); } while (0)
#define PG8_LDA(dst, b, h) do { _Pragma("unroll") for (int m = 0; m < 4; ++m) _Pragma("unroll") for (int k = 0; k < 2; ++k) dst[m][k] = *(const LAS bf16x8*)(lds + PG8_SA(b, h) + aoff + m * 2048 + k * 1024); } while (0)
#define PG8_LDB(dst, b, h) do { _Pragma("unroll") for (int n = 0; n < 2; ++n) _Pragma("unroll") for (int k = 0; k < 2; ++k) dst[n][k] = *(const LAS bf16x8*)(lds + PG8_SB(b, h) + boff + n * 2048 + k * 1024); } while (0)
#define PG8_MMA(ai, bj, At, Bt) do { __builtin_amdgcn_s_setprio(1); _Pragma("unroll") for (int m = 0; m < 4; ++m) _Pragma("unroll") for (int n = 0; n < 2; ++n) { \
        if (F8) acc[ai][bj][m][n] = __builtin_amdgcn_mfma_scale_f32_16x16x128_f8f6f4(cat8(Bt[n][0], Bt[n][1]), cat8(At[m][0], At[m][1]), acc[ai][bj][m][n], 0, 0, 0, 0, 0, 0); \
        else { _Pragma("unroll") for (int k = 0; k < 2; ++k) acc[ai][bj][m][n] = __builtin_amdgcn_mfma_f32_16x16x32_bf16(Bt[n][k], At[m][k], acc[ai][bj][m][n], 0, 0, 0); } } __builtin_amdgcn_s_setprio(0); } while (0)
#define PG8_WAIT_V(n) asm volatile("s_waitcnt vmcnt(" #n ")" ::: "memory")
#define PG8_WAIT_L(n) asm volatile("s_waitcnt lgkmcnt(" #n ")" ::: "memory")
#define PG8_WAIT_VR(rl) do { if (rl) asm volatile("s_waitcnt vmcnt(%0)" :: "i"(8 + Epi::MIN_STORES) : "memory"); else asm volatile("s_waitcnt vmcnt(8)" ::: "memory"); } while (0)
#define PG8_BAR __builtin_amdgcn_s_barrier()
#define PG8_SCHED __builtin_amdgcn_sched_barrier(0)
#define PG8_ZERO() do { _Pragma("unroll") for (int a = 0; a < 2; ++a) _Pragma("unroll") for (int b = 0; b < 2; ++b) _Pragma("unroll") for (int m = 0; m < 4; ++m) _Pragma("unroll") for (int n = 0; n < 2; ++n) acc[a][b][m][n] = (f32x4){0.f, 0.f, 0.f, 0.f}; } while (0)
    __builtin_amdgcn_sched_barrier(0);
    Unit cur, nxt; int ui = 0;
    if (!S.next(0, cur)) return;
    Acc acc; PG8_ZERO();
    bf16x8 At[4][2], B0[2][2], B1[2][2];
    unsigned c00, c01, c10, c11, n00, n01, n10, n11;
    PG8_AOFFS(cur, c00, c01, c10, c11);
    const char* cB = S.b_ptr(cur);
    PG8_STAGE(PG8_SB(0, 0), cB, voffB[0], voffB[1]); PG8_STAGE(PG8_SB(0, 1), cB + hstepB, voffB[0], voffB[1]); PG8_STAGE(PG8_SA(0, 0), A, c00, c01); PG8_STAGE(PG8_SA(0, 1), A, c10, c11);
    if (wr == 1) PG8_BAR;
    PG8_WAIT_V(2); PG8_BAR;
    PG8_STAGE(PG8_SB(1, 0), cB + kstep, voffB[0], voffB[1]); PG8_STAGE(PG8_SA(1, 0), A + kstep, c00, c01); PG8_STAGE(PG8_SB(1, 1), cB + hstepB + kstep, voffB[0], voffB[1]);
    PG8_WAIT_V(6); PG8_BAR;
    for (;;) {
        const bool has_next = S.next(ui + 1, nxt);
        const char* nB = cB; n00 = c00; n01 = c01; n10 = c10; n11 = c11;
        if (has_next) { PG8_AOFFS(nxt, n00, n01, n10, n11); nB = S.b_ptr(nxt); }
#define PG8_KBODY(t, last, rlx) do { \
            const char* a1 = A + (size_t)(t + 1) * kstep; \
            const char* a2 = last ? A : A + (size_t)(t + 2) * kstep; const char* b2 = last ? nB : cB + (size_t)(t + 2) * kstep; \
            const char* a3 = a2 + kstep; const char* b3 = b2 + kstep; \
            const unsigned s00 = last ? n00 : c00, s01 = last ? n01 : c01, s10 = last ? n10 : c10, s11 = last ? n11 : c11; \
            PG8_LDB(B0, 0, 0); PG8_LDB(B1, 0, 1); PG8_SCHED; PG8_LDA(At, 0, 0); PG8_STAGE(PG8_SA(1, 1), a1, c10, c11); \
            PG8_WAIT_VR(rlx); PG8_WAIT_L(0); PG8_BAR; PG8_MMA(0, 0, At, B0); PG8_MMA(0, 1, At, B1); PG8_BAR; PG8_SCHED; \
            PG8_LDA(At, 0, 1); PG8_STAGE(PG8_SB(0, 0), b2, voffB[0], voffB[1]); PG8_STAGE(PG8_SB(0, 1), b2 + hstepB, voffB[0], voffB[1]); PG8_STAGE(PG8_SA(0, 0), a2, s00, s01); \
            PG8_WAIT_VR(rlx); PG8_WAIT_L(0); PG8_BAR; PG8_MMA(1, 0, At, B0); PG8_MMA(1, 1, At, B1); PG8_BAR; PG8_SCHED; \
            PG8_LDB(B0, 1, 0); PG8_LDB(B1, 1, 1); PG8_SCHED; PG8_LDA(At, 1, 0); PG8_STAGE(PG8_SA(0, 1), a2, s10, s11); \
            PG8_WAIT_V(8); PG8_WAIT_L(0); PG8_BAR; PG8_MMA(0, 0, At, B0); PG8_MMA(0, 1, At, B1); PG8_BAR; PG8_SCHED; \
            PG8_LDA(At, 1, 1); PG8_STAGE(PG8_SB(1, 0), b3, voffB[0], voffB[1]); PG8_STAGE(PG8_SB(1, 1), b3 + hstepB, voffB[0], voffB[1]); PG8_STAGE(PG8_SA(1, 0), a3, s00, s01); \
            PG8_WAIT_V(8); PG8_WAIT_L(0); PG8_BAR; PG8_MMA(1, 0, At, B0); PG8_MMA(1, 1, At, B1); PG8_BAR; PG8_SCHED; \
        } while (0)
        if (Epi::HAS_MID) {
            _Pragma("unroll 1") for (int t = 0; t < nt / 2; t += 2) { const bool rl = (ui > 0) && (t == 0); PG8_KBODY(t, false, rl); }
            E.mid(acc, cur, wr, wc, fr, fq);
            _Pragma("unroll 1") for (int t = nt / 2; t < nt; t += 2) { const bool lastq = (t == nt - 2); PG8_KBODY(t, lastq, false); }
        } else {
            _Pragma("unroll 1") for (int t = 0; t < nt; t += 2) { const bool lastq = (t == nt - 2), rl = (ui > 0) && (t == 0); PG8_KBODY(t, lastq, rl); }
        }
#undef PG8_KBODY
        if (ALIGN_EPI) { if (wr == 0) PG8_BAR; }
        if (F8 && F8SH > 0) { constexpr float asc = 1.f / (float)(1 << (F8SH > 0 ? F8SH : 0));
            _Pragma("unroll") for (int a = 0; a < 2; ++a) _Pragma("unroll") for (int b = 0; b < 2; ++b) _Pragma("unroll") for (int m = 0; m < 4; ++m) _Pragma("unroll") for (int n = 0; n < 2; ++n) acc[a][b][m][n] = acc[a][b][m][n] * asc; }
        { int t3 = tid; asm volatile("" : "+v"(t3)); const int l3 = t3 & 63; E(acc, cur, wr, wc, l3 & 15, l3 >> 4); }
        if (!has_next) break;
        PG8_ZERO();
        cur = nxt; cB = nB; c00 = n00; c01 = n01; c10 = n10; c11 = n11; ++ui;
        if (ALIGN_EPI) { if (wr == 1) PG8_BAR; }
    }
    PG8_WAIT_V(0);
    if (!ALIGN_EPI) { if (wr == 0) PG8_BAR; }
    PG8_BAR;
#undef PG8_SA
#undef PG8_SB
#undef PG8_STAGE
#undef PG8_LDA
#undef PG8_LDB
#undef PG8_MMA
#undef PG8_WAIT_V
#undef PG8_WAIT_L
#undef PG8_WAIT_VR
#undef PG8_BAR
#undef PG8_SCHED
#undef PG8_ZERO
#undef PG8_AOFFS
}
struct DenseOrder {
    int nM, nN, nwg, G, c; unsigned lda2; const char* Bt; size_t btile;
    __device__ __forceinline__ void init(int M, int N, int K, int lda, const void* Bt_, int G_, int c_) { nM = M / BM; nN = N / BM; nwg = nM * nN; G = G_; c = c_; lda2 = (unsigned)lda * 2u; Bt = (const char*)Bt_; btile = (size_t)BM * K * 2; }
    __device__ __forceinline__ bool next(int i, Unit& u) const {
        const long L = (long)i * G + c; if (L >= nwg) return false;
        int wgid = (int)L; { const int q = nwg / 8, r = nwg % 8, xcd = wgid % 8, off = wgid / 8; wgid = (xcd < r ? xcd * (q + 1) : r * (q + 1) + (xcd - r) * q) + off; }
        const int nig = 8 * nN, gid = wgid / nig, fm = gid * 8, gsz = (nM - fm) < 8 ? (nM - fm) : 8;
        u.pm = fm + ((wgid % nig) % gsz); u.pn = (wgid % nig) / gsz; u.e = 0; u.slot = 0; return true;
    }
    __device__ __forceinline__ unsigned a_off(const Unit& u, int r) const { return (unsigned)(u.pm * BM + r) * lda2; }
    __device__ __forceinline__ unsigned a_koff(const Unit&) const { return 0u; }
    __device__ __forceinline__ const char* b_ptr(const Unit& u) const { return Bt + (size_t)u.pn * btile; }
};
struct EpiResid {
    static constexpr bool HAS_MID = false; static constexpr int MIN_STORES = 0;
    const float* __restrict__ x; float* __restrict__ out; unsigned char* __restrict__ xq;
    __device__ __forceinline__ void mid(Acc&, const Unit&, int, int, int, int) const {}
    __device__ __forceinline__ void operator()(const Acc& acc, const Unit& u, int wr, int wc, int fr, int fq) const {
        const int row0 = u.pm * BM + wr * 64 + fr, col0 = u.pn * BM + wc * 32 + 8 * fq;
#pragma unroll
        for (int ai = 0; ai < 2; ++ai)
#pragma unroll
            for (int m = 0; m < 4; ++m) { const size_t ro = (size_t)(row0 + ai * HALF + m * 16) * D + col0;
                f32x4 xv[2][2];
#pragma unroll
                for (int bj = 0; bj < 2; ++bj)
#pragma unroll
                    for (int n = 0; n < 2; ++n) xv[bj][n] = __builtin_nontemporal_load((const f32x4*)(x + ro + bj * HALF + 4 * n));
#pragma unroll
                for (int bj = 0; bj < 2; ++bj) { const f32x4 v0 = xv[bj][0] + acc[ai][bj][m][0], v1 = xv[bj][1] + acc[ai][bj][m][1];
                    *(f32x4*)(out + ro + bj * HALF) = v0; *(f32x4*)(out + ro + bj * HALF + 4) = v1;
                    u32x2 w; w.x = pk4f8c(v0[0], v0[1], v0[2], v0[3]); w.y = pk4f8c(v1[0], v1[1], v1[2], v1[3]);
                    *(u32x2*)(xq + ro + bj * HALF) = w; } }
    }
};
__device__ __forceinline__ float sigm(float v) { return __builtin_amdgcn_rcpf(1.f + __expf(-v)); }
struct EpiProj {
    static constexpr bool HAS_MID = false; static constexpr int MIN_STORES = 8;
    bf16 *u, *q, *k, *vT, *sga, *sgb; const float *qg, *kg;
    __device__ __forceinline__ void mid(Acc&, const Unit&, int, int, int, int) const {}
    __device__ __forceinline__ void operator()(const Acc& acc, const Unit& un, int wr, int wc, int fr, int fq) const {
        const int row0 = un.pm * BM + wr * 64 + fr, pn = un.pn;
        if (pn < 4) {
#pragma unroll
            for (int ai = 0; ai < 2; ++ai)
#pragma unroll
                for (int m = 0; m < 4; ++m) { const f32x4 a0 = acc[ai][0][m][0], a1 = acc[ai][0][m][1], g0 = acc[ai][1][m][0], g1 = acc[ai][1][m][1]; u32x4 w;
                    w.x = cvt_pk_bf16(a0[0] * sigm(g0[0]), a0[1] * sigm(g0[1])); w.y = cvt_pk_bf16(a0[2] * sigm(g0[2]), a0[3] * sigm(g0[3]));
                    w.z = cvt_pk_bf16(a1[0] * sigm(g1[0]), a1[1] * sigm(g1[1])); w.w = cvt_pk_bf16(a1[2] * sigm(g1[2]), a1[3] * sigm(g1[3]));
                    *(u32x4*)(u + (size_t)(row0 + ai * HALF + m * 16) * DC + 128 * pn + 32 * wc + 8 * fq) = w; }
        } else if (pn < 8) {
            const bool isq = pn < 6; const int hh = 4 * (pn & 1) + wc; const float* gg = isq ? qg : kg; bf16* dst = (isq ? q : k) + hh * 64 + 8 * fq; const float sc0 = isq ? 0.125f * 1.44269504089f : 1.f;
            f32x4 gv[2][2];
#pragma unroll
            for (int bj = 0; bj < 2; ++bj)
#pragma unroll
                for (int n = 0; n < 2; ++n) gv[bj][n] = *(const f32x4*)(gg + 32 * bj + 8 * fq + 4 * n);
#pragma unroll
            for (int ai = 0; ai < 2; ++ai)
#pragma unroll
                for (int m = 0; m < 4; ++m) { float ss = 0.f;
#pragma unroll
                    for (int bj = 0; bj < 2; ++bj)
#pragma unroll
                        for (int n = 0; n < 2; ++n) { const f32x4 v = acc[ai][bj][m][n]; ss += (v[0] * v[0] + v[1] * v[1]) + (v[2] * v[2] + v[3] * v[3]); }
                    ss += __shfl_xor(ss, 16); ss += __shfl_xor(ss, 32);
                    const float rs = rsqrtf(ss * (1.f / 64.f) + EPS) * sc0;
#pragma unroll
                    for (int bj = 0; bj < 2; ++bj) { const f32x4 v0 = acc[ai][bj][m][0] * gv[bj][0] * rs, v1 = acc[ai][bj][m][1] * gv[bj][1] * rs; u32x4 w;
                        w.x = cvt_pk_bf16(v0[0], v0[1]); w.y = cvt_pk_bf16(v0[2], v0[3]); w.z = cvt_pk_bf16(v1[0], v1[1]); w.w = cvt_pk_bf16(v1[2], v1[3]);
                        *(u32x4*)(dst + (size_t)(row0 + ai * HALF + m * 16) * 512 + 32 * bj) = w; } }
        } else if (pn < 10) {
            const int vc0 = 256 * (pn - 8) + 32 * wc + 8 * fq;
#pragma unroll
            for (int ai = 0; ai < 2; ++ai)
#pragma unroll
                for (int m = 0; m < 4; ++m)
#pragma unroll
                    for (int bj = 0; bj < 2; ++bj)
#pragma unroll
                        for (int n = 0; n < 2; ++n)
#pragma unroll
                            for (int i = 0; i < 4; ++i) vT[(size_t)(vc0 + 128 * bj + 4 * n + i) * S + row0 + ai * HALF + m * 16] = (bf16)f2bf(acc[ai][bj][m][n][i]);
        } else {
            bf16* dst = (pn < 14 ? sga : sgb) + 256 * ((pn - 10) & 3) + 32 * wc + 8 * fq;
#pragma unroll
            for (int ai = 0; ai < 2; ++ai)
#pragma unroll
                for (int m = 0; m < 4; ++m)
#pragma unroll
                    for (int bj = 0; bj < 2; ++bj) { const f32x4 v0 = acc[ai][bj][m][0], v1 = acc[ai][bj][m][1]; u32x4 w;
                        w.x = cvt_pk_bf16(sigm(v0[0]), sigm(v0[1])); w.y = cvt_pk_bf16(sigm(v0[2]), sigm(v0[3])); w.z = cvt_pk_bf16(sigm(v1[0]), sigm(v1[1])); w.w = cvt_pk_bf16(sigm(v1[2]), sigm(v1[3]));
                        *(u32x4*)(dst + (size_t)(row0 + ai * HALF + m * 16) * D + 128 * bj) = w; }
        }
    }
};
struct EpiMerge {
    static constexpr bool HAS_MID = true; static constexpr int MIN_STORES = 0;
    const bf16* __restrict__ sga; const bf16* __restrict__ sgb; bf16* __restrict__ mrg;
    static __device__ __forceinline__ float lo(unsigned w) { return __uint_as_float(w << 16); }
    static __device__ __forceinline__ float hi(unsigned w) { return __uint_as_float(w & 0xffff0000u); }
    __device__ __forceinline__ void mid(Acc& acc, const Unit& un, int wr, int wc, int fr, int fq) const {
        const size_t o0 = (size_t)(un.pm * BM + wr * 64 + fr) * D + un.pn * BM + 32 * wc + 8 * fq;
#pragma unroll
        for (int ai = 0; ai < 2; ++ai)
#pragma unroll
            for (int m = 0; m < 4; ++m)
#pragma unroll
                for (int bj = 0; bj < 2; ++bj) { const size_t off = o0 + (size_t)(ai * HALF + m * 16) * D + 128 * bj; const u32x4 a = __builtin_nontemporal_load((const u32x4*)(sga + off)), b = *(const u32x4*)(sgb + off);
                    f32x4& v0 = acc[ai][bj][m][0]; f32x4& v1 = acc[ai][bj][m][1];
                    v0[0] *= lo(a.x) * __builtin_amdgcn_rcpf(fmaxf(lo(b.x), 1e-6f)); v0[1] *= hi(a.x) * __builtin_amdgcn_rcpf(fmaxf(hi(b.x), 1e-6f));
                    v0[2] *= lo(a.y) * __builtin_amdgcn_rcpf(fmaxf(lo(b.y), 1e-6f)); v0[3] *= hi(a.y) * __builtin_amdgcn_rcpf(fmaxf(hi(b.y), 1e-6f));
                    v1[0] *= lo(a.z) * __builtin_amdgcn_rcpf(fmaxf(lo(b.z), 1e-6f)); v1[1] *= hi(a.z) * __builtin_amdgcn_rcpf(fmaxf(hi(b.z), 1e-6f));
                    v1[2] *= lo(a.w) * __builtin_amdgcn_rcpf(fmaxf(lo(b.w), 1e-6f)); v1[3] *= hi(a.w) * __builtin_amdgcn_rcpf(fmaxf(hi(b.w), 1e-6f));
                    asm volatile("" ::: "memory"); }
    }
    __device__ __forceinline__ void operator()(const Acc& acc, const Unit& un, int wr, int wc, int fr, int fq) const {
        const size_t o0 = (size_t)(un.pm * BM + wr * 64 + fr) * D + un.pn * BM + 32 * wc + 8 * fq;
#pragma unroll
        for (int ai = 0; ai < 2; ++ai)
#pragma unroll
            for (int m = 0; m < 4; ++m) { u32x4 b[2];
#pragma unroll
                for (int bj = 0; bj < 2; ++bj) b[bj] = *(const u32x4*)(sgb + o0 + (size_t)(ai * HALF + m * 16) * D + 128 * bj);
#pragma unroll
                for (int bj = 0; bj < 2; ++bj) { const f32x4 v0 = acc[ai][bj][m][0], v1 = acc[ai][bj][m][1]; const u32x4 bb = b[bj]; u32x4 w;
                    w.x = cvt_pk_bf16(v0[0] * fmaxf(lo(bb.x), 1e-6f), v0[1] * fmaxf(hi(bb.x), 1e-6f)); w.y = cvt_pk_bf16(v0[2] * fmaxf(lo(bb.y), 1e-6f), v0[3] * fmaxf(hi(bb.y), 1e-6f));
                    w.z = cvt_pk_bf16(v1[0] * fmaxf(lo(bb.z), 1e-6f), v1[1] * fmaxf(hi(bb.z), 1e-6f)); w.w = cvt_pk_bf16(v1[2] * fmaxf(lo(bb.w), 1e-6f), v1[3] * fmaxf(hi(bb.w), 1e-6f));
                    *(u32x4*)(mrg + o0 + (size_t)(ai * HALF + m * 16) * D + 128 * bj) = w; } }
    }
};

template <int MU, bool ROWS> struct MoeOrder {
    int nu; unsigned lda2; const char* Bt; unsigned estride, tstride;
    LAS int* ddesc; LAS int* drow; LAS float* dscale;
    static_assert(512 + MU * 1024 * (ROWS ? 2 : 1) <= LDS_CTL_OFF - AUX_OFF, "aux LDS");
    __device__ __forceinline__ void init(int G, int c, const int* ctl, int NP, int pn0, int NPS, const int* stok, const float* rowscale, bool shared_one, float rsc, unsigned lda2_, const void* Bt_, unsigned brow, int rows_e, LAS unsigned char* aux, int WID) {
        const int R = G >> 3, x = c & 7, r = c >> 3;
        const int tid0 = otid(WID); int ent = 0; if (tid0 < MU) { const int k0 = r + R * tid0; ent = ldc(ctl + C_XL + x * MAXT + (k0 / NP < MAXT ? k0 / NP : MAXT - 1)); }
        const int xn = ldc(ctl + C_XN + x);
        lda2 = lda2_; Bt = (const char*)Bt_; estride = (unsigned)rows_e * brow; tstride = (unsigned)BM * brow;
        ddesc = (LAS int*)aux; drow = (LAS int*)(aux + 512); dscale = (LAS float*)(aux + 512 + (ROWS ? MU * 1024 : 0));
        const int tid = tid0; const int total = xn * NP + 8 * NPS;
        nu = 0; if (r < R) for (int k = r; k < total && nu < MU; k += R) ++nu;
        if (tid < MU) { int k = r + R * tid, pm = 0, pn = 0, e = NE, ok = 0;
            if (tid < nu) { ok = 1;
                if (k < xn * NP) { pm = ent & 0xffff; pn = pn0 + k % NP; e = ent >> 16; }
                else { k -= xn * NP; pm = MAXT + x * 8 + k / NPS; pn = pn0 + k % NPS; e = NE; } }
            ddesc[4 * tid + 0] = pm; ddesc[4 * tid + 1] = pn; ddesc[4 * tid + 2] = e; ddesc[4 * tid + 3] = ok; }
        __syncthreads();
        for (int j = 0; j < nu; ++j) { const int pm = ddesc[4 * j], e = ddesc[4 * j + 2];
            for (int rr = tid; rr < BM; rr += NTHR) { const int row = pm * BM + rr;
                if (ROWS) { int tok = row - MAXSLOT; if (e < NE) { tok = stok[row]; tok = tok < 0 ? 0 : tok; } drow[j * BM + rr] = tok; }
                dscale[j * BM + rr] = ((shared_one && e >= NE) ? 1.f : rowscale[row]) * rsc; } }
        __syncthreads();
    }
    __device__ __forceinline__ bool next(int i, Unit& u) const {
        if (i >= nu) return false;
        u.pm = __builtin_amdgcn_readfirstlane(ddesc[4 * i]); u.pn = __builtin_amdgcn_readfirstlane(ddesc[4 * i + 1]); u.e = __builtin_amdgcn_readfirstlane(ddesc[4 * i + 2]); u.slot = i; return true;
    }
    __device__ __forceinline__ unsigned a_off(const Unit& u, int r_) const { return (unsigned)(ROWS ? drow[u.slot * BM + r_] : u.pm * BM + r_) * lda2; }
    __device__ __forceinline__ unsigned a_koff(const Unit&) const { return 0u; }
    __device__ __forceinline__ const char* b_ptr(const Unit& u) const { return Bt + (size_t)((unsigned)u.e * estride + (unsigned)u.pn * tstride); }
};
typedef MoeOrder<13, true> MoeGU; typedef MoeOrder<26, false> MoeDN;
struct EpiGateUp {
    static constexpr bool HAS_MID = false; static constexpr int MIN_STORES = 8;
    unsigned char* __restrict__ hmid; const LAS float* srs;
    __device__ __forceinline__ void mid(Acc&, const Unit&, int, int, int, int) const {}
    __device__ __forceinline__ void operator()(const Acc& acc, const Unit& un, int wr, int wc, int fr, int fq) const {
        const int r0 = un.pm * BM + wr * 64 + fr;
        unsigned char* dst = hmid + (size_t)r0 * DE + 128 * un.pn + 32 * wc + 8 * fq;
#pragma unroll
        for (int ai = 0; ai < 2; ++ai) { float rs[4];
#pragma unroll
            for (int m = 0; m < 4; ++m) rs[m] = srs[un.slot * BM + wr * 64 + fr + ai * HALF + m * 16];
#pragma unroll
            for (int m = 0; m < 4; ++m) { const f32x4 g0 = acc[ai][0][m][0] * rs[m], g1 = acc[ai][0][m][1] * rs[m], u0 = acc[ai][1][m][0] * rs[m], u1 = acc[ai][1][m][1] * rs[m]; u32x2 w;
                w.x = pk4f8c(g0[0] * sigm(g0[0]) * u0[0], g0[1] * sigm(g0[1]) * u0[1], g0[2] * sigm(g0[2]) * u0[2], g0[3] * sigm(g0[3]) * u0[3]);
                w.y = pk4f8c(g1[0] * sigm(g1[0]) * u1[0], g1[1] * sigm(g1[1]) * u1[1], g1[2] * sigm(g1[2]) * u1[2], g1[3] * sigm(g1[3]) * u1[3]);
                *(u32x2*)(dst + (size_t)(ai * HALF + m * 16) * DE) = w; } }
    }
};
struct EpiDown {
    static constexpr bool HAS_MID = false; static constexpr int MIN_STORES = 16;
    unsigned char* __restrict__ y; const LAS float* sw; unsigned char* __restrict__ ysh; unsigned char* __restrict__ ysc;
    __device__ __forceinline__ void mid(Acc&, const Unit&, int, int, int, int) const {}
    __device__ __forceinline__ void operator()(const Acc& acc, const Unit& un, int wr, int wc, int fr, int fq) const {
        const int r0 = un.pm * BM + wr * 64 + fr;
        unsigned char* dst = (un.e < NE ? y + (size_t)r0 * D : ysh + (size_t)(r0 - MAXSLOT) * D) + un.pn * BM + 64 * wc + 16 * fq;
        unsigned char* sc = ysc + (size_t)r0 * 16 + un.pn * 4 + wc;
#pragma unroll
        for (int ai = 0; ai < 2; ++ai) { float wt[4];
#pragma unroll
            for (int m = 0; m < 4; ++m) wt[m] = sw[un.slot * BM + wr * 64 + fr + ai * HALF + m * 16];
#pragma unroll
            for (int m = 0; m < 4; ++m) {
                f32x4 v[2][2]; float am = 0.f;
#pragma unroll
                for (int bj = 0; bj < 2; ++bj)
#pragma unroll
                    for (int n = 0; n < 2; ++n) { v[bj][n] = acc[ai][bj][m][n] * wt[m];
                        am = fmaxf(am, fmaxf(fmaxf(fabsf(v[bj][n][0]), fabsf(v[bj][n][1])), fmaxf(fabsf(v[bj][n][2]), fabsf(v[bj][n][3])))); }
                am = fmaxf(am, __shfl_xor(am, 16)); am = fmaxf(am, __shfl_xor(am, 32));
                const unsigned eb = (__float_as_uint(fmaxf(am * (1.f / 127.f), 1e-30f)) + 0x7fffffu) >> 23;
                const float inv = __uint_as_float((254u - eb) << 23);
                u32x4 w;
#pragma unroll
                for (int bj = 0; bj < 2; ++bj)
#pragma unroll
                    for (int n = 0; n < 2; ++n) { const f32x4 t = v[bj][n]; unsigned pw = 0u;
                        pw = __builtin_amdgcn_cvt_pk_u8_f32(rintf(fmaf(t[0], inv, 128.f)), 0, pw); pw = __builtin_amdgcn_cvt_pk_u8_f32(rintf(fmaf(t[1], inv, 128.f)), 1, pw);
                        pw = __builtin_amdgcn_cvt_pk_u8_f32(rintf(fmaf(t[2], inv, 128.f)), 2, pw); pw = __builtin_amdgcn_cvt_pk_u8_f32(rintf(fmaf(t[3], inv, 128.f)), 3, pw);
                        w[2 * bj + n] = pw; }
                *(u32x4*)(dst + (size_t)(ai * HALF + m * 16) * D) = w;
                if (fq == 0) sc[(size_t)(ai * HALF + m * 16) * 16] = (unsigned char)eb;
            }
        }
    }
};
}

constexpr int N_ECVT = 3 * (NE + 1) * (D / 64) * (DE / 64);
struct CvtDesc { const float* W; unsigned char* WT; const float* gk; int N, ldo, mode, k0, n0; float wsc; };
__device__ __forceinline__ void cvt_desc(const Params& p, int it, CvtDesc& d) {
    constexpr int I_E = (D / 64) * (DE / 64);
    const int kind = it / ((NE + 1) * I_E), rr = it % ((NE + 1) * I_E), e = rr / I_E, item = rr % I_E;
    if (kind < 2) { d.W = (kind == 0 ? (e < NE ? p.w_eg + (size_t)e * D * DE : p.w_sg) : (e < NE ? p.w_eu + (size_t)e * D * DE : p.w_su)); d.WT = p.ws + WS_WGU + (size_t)e * 512 * D; d.gk = p.norm_ffn_g;
        d.N = DE; d.ldo = D; d.mode = 1 + kind; d.wsc = WGU_SC; }
    else { d.W = e < NE ? p.w_ed + (size_t)e * DE * D : p.w_sd; d.WT = p.ws + WS_WD + (size_t)e * D * DE; d.gk = nullptr; d.N = D; d.ldo = DE; d.mode = 0; d.wsc = WD_SC; }
    const int nblk = d.N / 64; d.k0 = 64 * (item / nblk); d.n0 = 64 * (item % nblk);
}
__device__ __forceinline__ void cvt_load(const CvtDesc& d, f32x4 (&v)[16], int lane) {
    const int kr = lane >> 4, n4 = (lane & 15) * 4;
#pragma unroll
    for (int i = 0; i < 16; ++i) { const int kk = 4 * (kr + 4 * (i >> 2)) + (i & 3); v[i] = __builtin_nontemporal_load((const f32x4*)(d.W + (size_t)(d.k0 + kk) * d.N + d.n0 + n4)); }
}
__device__ __forceinline__ void cvt_finish(const CvtDesc& d, f32x4 (&v)[16], float* scr, int lane) {
    const int kr = lane >> 4, n4 = (lane & 15) * 4; unsigned* tl = (unsigned*)scr;
#pragma unroll
    for (int q = 0; q < 4; ++q) { const int kq = kr + 4 * q; f32x4 x0 = v[4 * q], x1 = v[4 * q + 1], x2 = v[4 * q + 2], x3 = v[4 * q + 3];
        float s0 = d.wsc, s1 = d.wsc, s2 = d.wsc, s3 = d.wsc;
        if (d.gk) { const f32x4 gv = *(const f32x4*)(d.gk + d.k0 + 4 * kq); s0 *= gv[0]; s1 *= gv[1]; s2 *= gv[2]; s3 *= gv[3]; }
        x0 = x0 * s0; x1 = x1 * s1; x2 = x2 * s2; x3 = x3 * s3;
        u32x4 w; w.x = pk4f8(x0[0], x1[0], x2[0], x3[0]); w.y = pk4f8(x0[1], x1[1], x2[1], x3[1]); w.z = pk4f8(x0[2], x1[2], x2[2], x3[2]); w.w = pk4f8(x0[3], x1[3], x2[3], x3[3]);
        *(u32x4*)(tl + kq * 64 + (n4 ^ (16 * q))) = w; }
    asm volatile("s_waitcnt lgkmcnt(0)" ::: "memory");
    const int c = lane & 3;
#pragma unroll
    for (int j = 0; j < 4; ++j) { const int n = (lane >> 2) + 16 * j; const unsigned* sp = tl + (4 * c) * 64 + (n ^ (16 * c));
        u32x4 o; o.x = sp[0]; o.y = sp[64]; o.z = sp[128]; o.w = sp[192];
        const int cn = d.n0 + n; const int row = d.mode == 0 ? MapDown{}(cn) : 256 * (cn >> 7) + 128 * (d.mode - 1) + (cn & 127);
        __builtin_nontemporal_store(o, (u32x4*)(d.WT + (size_t)row * d.ldo + d.k0 + 16 * c)); }
    asm volatile("s_waitcnt lgkmcnt(0)" ::: "memory");
}
__device__ __forceinline__ void expert_cvt_loop(const Params& p, int gw, int NGW, float* scr, int lane) {
    CvtDesc da, db; f32x4 va[16], vb[16];
    int it = gw; if (it >= N_ECVT) return;
    cvt_desc(p, it, da); cvt_load(da, va, lane);
    for (;;) {
        int itn = it + NGW; const bool hb = itn < N_ECVT;
        if (hb) { cvt_desc(p, itn, db); cvt_load(db, vb, lane); }
        cvt_finish(da, va, scr, lane);
        if (!hb) break;
        it = itn; itn = it + NGW; const bool ha = itn < N_ECVT;
        if (ha) { cvt_desc(p, itn, da); cvt_load(da, va, lane); }
        cvt_finish(db, vb, scr, lane);
        if (!ha) break;
        it = itn;
    }
}

#define PHASE_VARS const int tid = otid(WID), lane = tid & 63, wave = owid(WID), gw = blockIdx.x * NWAVES + wave; float* wscr = (float*)(lds + wave * WSCR_BYTES); (void)lane; (void)gw; (void)wscr;
typedef const __attribute__((address_space(4))) Params* KParams;
__device__ __forceinline__ Params load_params() {
#if defined(__HIP_DEVICE_COMPILE__)
    KParams q = (KParams)__builtin_amdgcn_kernarg_segment_ptr(); asm volatile("" : "+s"(q)); Params r; __builtin_memcpy(&r, (const __attribute__((address_space(4))) void*)q, sizeof(Params)); return r;
#else
    return Params{};
#endif
}
#define PHASE_P const Params p = load_params(); unsigned char* ws = p.ws; int* ctl = (int*)(ws + WS_CTL); (void)ctl;
__global__ void __launch_bounds__(NTHR, 2) mk_fwd(Params p_arg) {
    extern __shared__ __attribute__((aligned(16))) unsigned char lds[];
    const int G = gridDim.x, NGW = G * NWAVES;
    const int WID = __builtin_amdgcn_readfirstlane(threadIdx.x >> 6);
    for (int u = otid(WID); u < (LDS_BYTES - LDS_CTL_OFF) / 4; u += NTHR) ((unsigned*)(lds + LDS_CTL_OFF))[u] = 0u;
    __syncthreads();
    XcdBarrier bar = xcd_barrier_post((unsigned*)(p_arg.ws + WS_CTL) + CW_BAR, (volatile LAS unsigned*)(lds + LDS_CTL_OFF), otid(WID) == 0);
#define xcd_barrier(b) xcd_barrier_(b, otid(WID) == 0)

    {
        PHASE_P
        PHASE_VARS
        constexpr int I_IN = (D / 64) * (DIN / 64), I_CO = (512 / 64) * (D / 64), I_O = (D / 64) * (D / 64), I_R = D / 64, I_E = (D / 64) * (DE / 64);
        constexpr int NMIX = I_IN + 2 * I_CO + I_O + 2 * I_R, NIT = NMIX; (void)I_E;
        for (int rep = 0; rep < REPS(10); ++rep)
        for (int it = gw; it < NIT; it += NGW) {
            int r = it;
            if (r < I_IN) { transpose_item<false>(p.w_in, D, DIN, (bf16*)(ws + WS_WIN), D, 0, MapIn{}, nullptr, wscr, r, lane); continue; } r -= I_IN;
            if (r < I_CO) { transpose_item<false>(p.w_conv_out, 512, D, (bf16*)(ws + WS_WCAT), D, 0, MapId{0}, nullptr, wscr, r, lane); continue; } r -= I_CO;
            if (r < I_CO) { transpose_item<false>(p.w_attn_out, 512, D, (bf16*)(ws + WS_WCAT), D, 512, MapId{0}, nullptr, wscr, r, lane); continue; } r -= I_CO;
            if (r < I_O) { transpose_item<false>(p.w_o, D, D, (bf16*)(ws + WS_WO), D, 0, MapId{0}, nullptr, wscr, r, lane); continue; } r -= I_O;
            if (r < I_R) { transpose_item<false>(p.w_router, D, NE, (bf16*)(ws + WS_WRH), D, 0, MapId{0}, p.norm_ffn_g, wscr, r, lane); continue; } r -= I_R;
            transpose_item<true>(p.w_router, D, NE, (bf16*)(ws + WS_WRL), D, 0, MapId{0}, p.norm_ffn_g, wscr, r, lane);
        }
        for (int rep = 0; rep < REPS(11); ++rep)
        for (int m = gw; m < S; m += NGW) rmsnorm_row(p.x + (size_t)m * D, p.norm_mix_g, (bf16*)(ws + WS_H) + (size_t)m * D, lane);
    }
    xcd_barrier(bar);
    {
        PHASE_P
        const int q8 = (int)(blockIdx.x >> 3), x8 = (int)(blockIdx.x & 7); const bool split = (G == 256), streamer = split && ((q8 & 3) == 3);
        if (!streamer) {
            pg8::DenseOrder So; So.init(S, DIN, D, D, ws + WS_WIN, split ? 192 : G, split ? 8 * (q8 - (q8 >> 2)) + x8 : (int)blockIdx.x);
            pg8::EpiProj E{(bf16*)(ws + WS_U), (bf16*)(ws + WS_Q), (bf16*)(ws + WS_K), (bf16*)(ws + WS_VT), (bf16*)(ws + WS_SGA), (bf16*)(ws + WS_SGB), p.q_norm_g, p.k_norm_g};
            pg8::gemm_phase<pg8::EpiProj, pg8::DenseOrder, true>((LAS unsigned char*)lds, (const char*)(ws + WS_H), D, So, E, WID);
        } else {
            PHASE_VARS
            expert_cvt_loop(p, (8 * (q8 >> 2) + x8) * NWAVES + wave, 64 * NWAVES, wscr, lane);
        }
    }
#if PROBE == 1
    {
        PHASE_P
        pg8::DenseOrder So; So.init(S, DIN, D, D, ws + WS_WIN, G, (int)blockIdx.x);
        pg8::EpiProj E{(bf16*)(ws + WS_U), (bf16*)(ws + WS_Q), (bf16*)(ws + WS_K), (bf16*)(ws + WS_VT), (bf16*)(ws + WS_SGA), (bf16*)(ws + WS_SGB), p.q_norm_g, p.k_norm_g};
        pg8::gemm_phase<pg8::EpiProj, pg8::DenseOrder, true>((LAS unsigned char*)lds, (const char*)(ws + WS_H), D, So, E, WID);
    }
#endif
    xcd_barrier(bar);
    {
        PHASE_P
        PHASE_VARS
        const bool docvt = (G != 256), cvt_first = docvt && (((blockIdx.x >> 3) & 1) != 0);
        if (cvt_first) { for (int rep = 0; rep < REPS(22); ++rep) expert_cvt_loop(p, gw, NGW, wscr, lane); __syncthreads(); }
        conv_phase(p, lds, G, WID);
        for (int rep = 0; rep < REPS(21); ++rep) attn_phase(p, lds, G, WID);
        if (docvt && !cvt_first) { __syncthreads(); for (int rep = 0; rep < REPS(22); ++rep) expert_cvt_loop(p, gw, NGW, wscr, lane); }
    }
    xcd_barrier(bar);
    {
        PHASE_P
        pg8::DenseOrder So; So.init(S, D, D, D, ws + WS_WCAT, G, (int)blockIdx.x);
        pg8::EpiMerge E{(const bf16*)(ws + WS_SGA), (const bf16*)(ws + WS_SGB), (bf16*)(ws + WS_MRG)};
        pg8::gemm_phase<pg8::EpiMerge, pg8::DenseOrder, true>((LAS unsigned char*)lds, (const char*)(ws + WS_U2), D, So, E, WID);
    }
#if PROBE == 3
    {
        PHASE_P
        pg8::DenseOrder So; So.init(S, D, D, D, ws + WS_WCAT, G, (int)blockIdx.x);
        pg8::EpiMerge E{(const bf16*)(ws + WS_SGA), (const bf16*)(ws + WS_SGB), (bf16*)(ws + WS_MRG)};
        pg8::gemm_phase<pg8::EpiMerge, pg8::DenseOrder, true>((LAS unsigned char*)lds, (const char*)(ws + WS_U2), D, So, E, WID);
    }
#endif
    xcd_barrier(bar);
    {
        PHASE_P
        pg8::DenseOrder So; So.init(S, D, D, D, ws + WS_WO, G, (int)blockIdx.x);
        pg8::EpiResid E{p.x, p.out, ws + WS_H};
        pg8::gemm_phase<pg8::EpiResid, pg8::DenseOrder, true>((LAS unsigned char*)lds, (const char*)(ws + WS_MRG), D, So, E, WID);
    }
#if PROBE == 4
    {
        PHASE_P
        pg8::DenseOrder So; So.init(S, D, D, D, ws + WS_WO, G, (int)blockIdx.x);
        pg8::EpiResid E{p.x, p.out, ws + WS_H};
        pg8::gemm_phase<pg8::EpiResid, pg8::DenseOrder, true>((LAS unsigned char*)lds, (const char*)(ws + WS_MRG), D, So, E, WID);
    }
#endif
    xcd_barrier(bar);
    {
        PHASE_P
        PHASE_VARS
        constexpr int RST = 528, PART = 64 * RST, BUF = 2 * PART;
        const bf16* wrh = (const bf16*)(ws + WS_WRH); const bf16* wrl = (const bf16*)(ws + WS_WRL); float* srs = (float*)(ws + WS_SRS);
        int* hist = (int*)(lds + LDS_CTL_OFF + 256); float* lgs = (float*)lds;
        const int g = lane >> 4, li = lane & 15, tt = wave >> 1, nh = wave & 1;
        for (int rep = 0; rep < REPS(50); ++rep)
        for (int blk = blockIdx.x; blk < S / 64; blk += G) {
            if (tid < NE) hist[tid] = 0;
            u32x4 st[8];
            const unsigned goff = (unsigned)(((tid >> 5) * D + (tid & 31) * 8) * 2), loff = (unsigned)((tid >> 5) * RST + (tid & 31) * 16);
#define R_LOAD(c) do { _Pragma("unroll") for (int j = 0; j < 8; ++j) { const char* ub = (const char*)((j >> 2) ? wrl : wrh) + (size_t)(16 * (j & 3)) * D * 2 + (c) * 512; \
                st[j] = *(const u32x4*)(ub + goff); } } while (0)
#define R_WRITE(b) do { _Pragma("unroll") for (int j = 0; j < 8; ++j) *(u32x4*)(lds + (b) * BUF + (j >> 2) * PART + 16 * (j & 3) * RST + loff) = st[j]; } while (0)
            const float* xr = p.out + (size_t)(blk * 64 + tt * 16 + li) * D + 8 * g;
            f32x4 acc[2]; float ssq = 0.f;
            for (int rep2 = 0; rep2 < REPS(51); ++rep2) {
            R_LOAD(0); R_WRITE(0); __syncthreads();
            ssq = 0.f; acc[0] = (f32x4){0.f, 0.f, 0.f, 0.f}; acc[1] = acc[0];
            f32x4 xv[8][2];
#pragma unroll
            for (int s8 = 0; s8 < 8; ++s8) { xv[s8][0] = *(const f32x4*)(xr + 32 * s8); xv[s8][1] = *(const f32x4*)(xr + 32 * s8 + 4); }
#pragma unroll 1
            for (int c = 0; c < 4; ++c) {
                if (c < 3) R_LOAD(c + 1);
                const unsigned char* bb = lds + (c & 1) * BUF + (32 * nh + li) * RST + 16 * g;
#pragma unroll
                for (int hf = 0; hf < 2; ++hf) {
#pragma unroll
                    for (int s4 = 0; s4 < 4; ++s4) { const int s8 = 4 * hf + s4;
                        const f32x4 x0 = xv[s8][0], x1 = xv[s8][1];
                        ssq += (x0[0] * x0[0] + x0[1] * x0[1]) + (x0[2] * x0[2] + x0[3] * x0[3]) + (x1[0] * x1[0] + x1[1] * x1[1]) + (x1[2] * x1[2] + x1[3] * x1[3]);
                        union { bf16x8 v; unsigned w[4]; } ah, al;
                        ah.w[0] = pk2(x0[0], x0[1]); ah.w[1] = pk2(x0[2], x0[3]); ah.w[2] = pk2(x1[0], x1[1]); ah.w[3] = pk2(x1[2], x1[3]);
                        al.w[0] = pk2(x0[0] - bf2f(ah.w[0] & 0xffff), x0[1] - bf2f(ah.w[0] >> 16)); al.w[1] = pk2(x0[2] - bf2f(ah.w[1] & 0xffff), x0[3] - bf2f(ah.w[1] >> 16));
                        al.w[2] = pk2(x1[0] - bf2f(ah.w[2] & 0xffff), x1[1] - bf2f(ah.w[2] >> 16)); al.w[3] = pk2(x1[2] - bf2f(ah.w[3] & 0xffff), x1[3] - bf2f(ah.w[3] >> 16));
#pragma unroll
                        for (int n2 = 0; n2 < 2; ++n2) { const bf16x8 wh = *(const bf16x8*)(bb + n2 * 16 * RST + 64 * s8), wl = *(const bf16x8*)(bb + PART + n2 * 16 * RST + 64 * s8);
                            acc[n2] = __builtin_amdgcn_mfma_f32_16x16x32_bf16(wh, ah.v, acc[n2], 0, 0, 0);
                            acc[n2] = __builtin_amdgcn_mfma_f32_16x16x32_bf16(wh, al.v, acc[n2], 0, 0, 0);
                            acc[n2] = __builtin_amdgcn_mfma_f32_16x16x32_bf16(wl, ah.v, acc[n2], 0, 0, 0); } }
                    if (c < 3) {
#pragma unroll
                        for (int s4 = 0; s4 < 4; ++s4) { const int s8 = 4 * hf + s4; xv[s8][0] = *(const f32x4*)(xr + (c + 1) * 256 + 32 * s8); xv[s8][1] = *(const f32x4*)(xr + (c + 1) * 256 + 32 * s8 + 4); } }
                }
                if (c < 3) R_WRITE((c + 1) & 1);
                __syncthreads();
            }
            }
#undef R_LOAD
#undef R_WRITE
            ssq += __shfl_xor(ssq, 16); ssq += __shfl_xor(ssq, 32);
            const float rs = rsqrtf(ssq * (1.f / D) + EPS);
            if (g == 0 && nh == 0) srs[MAXSLOT + blk * 64 + tt * 16 + li] = rs;
#pragma unroll
            for (int n2 = 0; n2 < 2; ++n2)
#pragma unroll
                for (int r = 0; r < 4; ++r) lgs[(tt * 16 + li) * 65 + 32 * nh + 16 * n2 + 4 * g + r] = acc[n2][r] * rs;
            __syncthreads();
            for (int rep3 = 0; rep3 < REPS(52); ++rep3)
            {   int* hh = hist + (rep3 ? 64 : 0);
                float* gsh = (float*)(lds + 49152); float* wsel = (float*)(lds + 32768);
                const int tok = tid >> 3, j = tid & 7, t = blk * 64 + tok;
                float sc[8], b[8];
#pragma unroll
                for (int i = 0; i < 8; ++i) { sc[i] = sigmoidf_(lgs[tok * 65 + 8 * j + i]); b[i] = sc[i] + p.router_bias[8 * j + i]; }
                { float m1 = -3.0e38f, m2 = -3.0e38f;
#pragma unroll
                  for (int i = 0; i < 8; ++i) { const float v = b[i]; if (v > m1) { m2 = m1; m1 = v; } else if (v > m2) m2 = v; }
                  gsh[tok * 8 + j] = m1 + m2; }
                asm volatile("s_waitcnt lgkmcnt(0)" ::: "memory");
                bool mine;
                { const f32x4 ga = *(const f32x4*)(gsh + tok * 8), gb = *(const f32x4*)(gsh + tok * 8 + 4);
                  const float gq[8] = {ga[0], ga[1], ga[2], ga[3], gb[0], gb[1], gb[2], gb[3]}; const float gme = (j == 0 ? gq[0] : j == 1 ? gq[1] : j == 2 ? gq[2] : j == 3 ? gq[3] : j == 4 ? gq[4] : j == 5 ? gq[5] : j == 6 ? gq[6] : gq[7]);
                  int r = 0;
#pragma unroll
                  for (int q = 0; q < 8; ++q) r += (gq[q] > gme || (gq[q] == gme && q < j)) ? 1 : 0;
                  mine = r < TOPG; }
                unsigned taken = mine ? 0u : 0xffu; float wpart = 0.f;
                int* tidx = (int*)(ws + WS_TIDX) + t * 8;
#define DPPF(x, ctrl) __uint_as_float((unsigned)__builtin_amdgcn_update_dpp(0, (int)__float_as_uint(x), ctrl, 0xf, 0xf, true))
#define DPPI(x, ctrl) __builtin_amdgcn_update_dpp(0, x, ctrl, 0xf, 0xf, true)
#pragma unroll 1
                for (int kq = 0; kq < TOPK; ++kq) {
                    float bv = -3.0e38f, bs = 0.f; int bi = 64;
#pragma unroll
                    for (int i = 0; i < 8; ++i) { const bool ok = !((taken >> i) & 1u) && b[i] > bv; bv = ok ? b[i] : bv; bs = ok ? sc[i] : bs; bi = ok ? 8 * j + i : bi; }
                    float mv = bv; int mi = bi;
#pragma unroll
                    for (int st = 0; st < 3; ++st) { const int ctrl = st == 0 ? 0xB1 : (st == 1 ? 0x4E : 0x141);
                        const float ov = st == 0 ? DPPF(mv, 0xB1) : (st == 1 ? DPPF(mv, 0x4E) : DPPF(mv, 0x141)); const int oi = st == 0 ? DPPI(mi, 0xB1) : (st == 1 ? DPPI(mi, 0x4E) : DPPI(mi, 0x141)); (void)ctrl;
                        const bool tk = ov > mv || (ov == mv && oi < mi); mv = tk ? ov : mv; mi = tk ? oi : mi; }
                    if (mi == bi && bi < 64) { taken |= 1u << (bi & 7); wpart += bs; tidx[kq] = bi; wsel[tok * 8 + kq] = bs; atomicAdd(hh + bi, 1); }
                }
#undef DPPF
#undef DPPI
                float wsum = wpart; wsum += __shfl_xor(wsum, 1); wsum += __shfl_xor(wsum, 2); wsum += __shfl_xor(wsum, 4);
                asm volatile("s_waitcnt lgkmcnt(0)" ::: "memory");
                ((float*)(ws + WS_TW))[t * 8 + j] = wsel[tok * 8 + j] * (ROUTE_SCALE / wsum);
            }
            __syncthreads();
            if (tid < NE) ((int*)(ws + WS_CNTB))[blk * NE + tid] = hist[tid];
            __syncthreads();
        }
    }
    xcd_barrier(bar);
    {
        PHASE_P
        PHASE_VARS
        int* s_part = (int*)lds; int* s_pre = s_part + 512; int* s_tot = s_pre + 512; int* s_base = s_tot + 64; int* s_pad = s_base + 64; int* s_start = s_pad + 64; int* s_cur = s_start + 80;
        const int* cntb = (const int*)(ws + WS_CNTB);
        int* stok = (int*)(ws + WS_STOK); float* sw = (float*)(ws + WS_SW); int* tslot = (int*)(ws + WS_TSLOT); float* srs = (float*)(ws + WS_SRS);
        const int* tidx = (const int*)(ws + WS_TIDX); const float* tw = (const float*)(ws + WS_TW);
        for (int rep = 0; rep < REPS(60); ++rep)
        for (int blk = blockIdx.x; blk < S / 64; blk += G) {
            { const int e = tid & 63, part = tid >> 6; int a = 0, b = 0;
              for (int w = 32 * part; w < 32 * part + 32; ++w) { const int v = cntb[w * NE + e]; a += v; b += (w < blk) ? v : 0; }
              s_part[tid] = a; s_pre[tid] = b; }
            __syncthreads();
            if (tid < NE) { int a = 0, b = 0;
#pragma unroll
                for (int q = 0; q < 8; ++q) { a += s_part[q * 64 + tid]; b += s_pre[q * 64 + tid]; }
                s_tot[tid] = a; s_base[tid] = b; s_pad[tid] = (a + 255) >> 8; s_cur[tid] = 0; }
            __syncthreads();
            if (tid < NE) {
                const int v = s_pad[tid]; int inc = v;
#pragma unroll
                for (int o = 1; o < 64; o <<= 1) { const int t = __shfl_up(inc, o); if (lane >= o) inc += t; }
                s_start[tid] = (inc - v) * 256; if (tid == NE - 1) s_start[NE] = inc * 256; }
            __syncthreads();
            if (blk == 0) {
                if (tid < NE) { const int st = s_start[tid] >> 8; for (int j = 0; j < s_pad[tid]; ++j) ctl[C_TEXP + st + j] = tid; }
                if (tid == 0) ctl[C_NT] = s_start[NE] >> 8;
                int* eg = s_cur + 64;
                if (tid < NE) { int rank = 0; for (int e = 0; e < NE; ++e) rank += (s_pad[e] > s_pad[tid] || (s_pad[e] == s_pad[tid] && e < tid)) ? 1 : 0; eg[tid] = ((rank >> 3) & 1) ? 7 - (rank & 7) : (rank & 7); }
                __syncthreads();
                if (tid < NE) { const int x = eg[tid]; int off = 0, tot = 0;
                    for (int e = 0; e < NE; ++e) { const int pe = (eg[e] == x) ? s_pad[e] : 0; tot += pe; off += (e < tid) ? pe : 0; }
                    const int st = s_start[tid] >> 8; for (int j = 0; j < s_pad[tid]; ++j) ctl[C_XL + x * MAXT + off + j] = (st + j) | (tid << 16);
                    ctl[C_XN + x] = tot; }
            }
            if (blk < NE) { const int e = blk; const int lo = s_start[e] + s_tot[e], hi = s_start[e + 1]; for (int sl = lo + tid; sl < hi; sl += NTHR) { stok[sl] = -1; sw[sl] = 0.f; srs[sl] = 0.f; } }
            { const int i = blk * 512 + tid; const int e = tidx[i]; const int pos = atomicAdd(s_cur + e, 1); const int slot = s_start[e] + s_base[e] + pos;
              stok[slot] = i >> 3; sw[slot] = tw[i]; tslot[i] = slot; srs[slot] = srs[MAXSLOT + (i >> 3)]; }
            __syncthreads();
        }
    }
    xcd_barrier(bar);
    {
        PHASE_P
        pg8::MoeGU So; So.init(G, (int)blockIdx.x, ctl, 2, 0, 2, (const int*)(ws + WS_STOK), (const float*)(ws + WS_SRS), false, 1.f / WGU_SC, (unsigned)D, ws + WS_WGU, (unsigned)D, 512, (LAS unsigned char*)lds + AUX_OFF, WID);
        pg8::EpiGateUp E{ws + WS_HMID, So.dscale};
        pg8::gemm_phase<pg8::EpiGateUp, pg8::MoeGU, true, 0>((LAS unsigned char*)lds, (const char*)(ws + WS_H), D / 2, So, E, WID);
    }
#if PROBE == 7
    {
        PHASE_P
        pg8::MoeGU So; So.init(G, (int)blockIdx.x, ctl, 2, 0, 2, (const int*)(ws + WS_STOK), (const float*)(ws + WS_SRS), false, 1.f / WGU_SC, (unsigned)D, ws + WS_WGU, (unsigned)D, 512, (LAS unsigned char*)lds + AUX_OFF, WID);
        pg8::EpiGateUp E{ws + WS_HMID, So.dscale};
        pg8::gemm_phase<pg8::EpiGateUp, pg8::MoeGU, true, 0>((LAS unsigned char*)lds, (const char*)(ws + WS_H), D / 2, So, E, WID);
    }
#endif
    xcd_barrier(bar);
    {
        PHASE_P
        pg8::MoeDN So; So.init(G, (int)blockIdx.x, ctl, 4, 0, 4, nullptr, (const float*)(ws + WS_SW), true, 1.f / WD_SC, (unsigned)DE, ws + WS_WD, (unsigned)DE, 1024, (LAS unsigned char*)lds + AUX_OFF, WID);
        pg8::EpiDown E{(unsigned char*)(ws + WS_Y), So.dscale, (unsigned char*)(ws + WS_YSH), (unsigned char*)(ws + WS_YSC)};
        int kq = DE / 2; asm volatile("" : "+s"(kq));
        pg8::gemm_phase<pg8::EpiDown, pg8::MoeDN, true, 0>((LAS unsigned char*)lds, (const char*)(ws + WS_HMID), kq, So, E, WID);
    }
#if PROBE == 8
    {
        PHASE_P
        pg8::MoeDN So; So.init(G, (int)blockIdx.x, ctl, 4, 0, 4, nullptr, (const float*)(ws + WS_SW), true, 1.f / WD_SC, (unsigned)DE, ws + WS_WD, (unsigned)DE, 1024, (LAS unsigned char*)lds + AUX_OFF, WID);
        pg8::EpiDown E{(unsigned char*)(ws + WS_Y), So.dscale, (unsigned char*)(ws + WS_YSH), (unsigned char*)(ws + WS_YSC)};
        int kq = DE / 2; asm volatile("" : "+s"(kq));
        pg8::gemm_phase<pg8::EpiDown, pg8::MoeDN, true, 0>((LAS unsigned char*)lds, (const char*)(ws + WS_HMID), kq, So, E, WID);
    }
#endif
    xcd_barrier(bar);
    {
        PHASE_P
        PHASE_VARS
        const int* tslot = (const int*)(ws + WS_TSLOT); const unsigned char* y = (const unsigned char*)(ws + WS_Y); const unsigned char* ysh = (const unsigned char*)(ws + WS_YSH); const unsigned char* ysc = (const unsigned char*)(ws + WS_YSC);
        for (int rep = 0; rep < REPS(9); ++rep) {
        const float ys = rep == 0 ? 1.f : 0.f;
        for (int t = gw; t < S; t += NGW) {
            const int* ts = tslot + t * 8; float* o = p.out + (size_t)t * D + 16 * lane;
            u32x4 v[TOPK + 1]; float sc[TOPK + 1];
#pragma unroll
            for (int kq = 0; kq < TOPK; ++kq) { const int sl = ts[kq]; v[kq] = __builtin_nontemporal_load((const u32x4*)(y + (size_t)sl * D + 16 * lane)); sc[kq] = __uint_as_float((unsigned)ysc[(size_t)sl * 16 + (lane >> 2)] << 23); }
            v[TOPK] = __builtin_nontemporal_load((const u32x4*)(ysh + (size_t)t * D + 16 * lane)); sc[TOPK] = __uint_as_float((unsigned)ysc[(size_t)(MAXSLOT + t) * 16 + (lane >> 2)] << 23);
            f32x4 a[4]; float ssum = 0.f;
#pragma unroll
            for (int j = 0; j < 4; ++j) a[j] = *(const f32x4*)(o + 4 * j);
#pragma unroll
            for (int kq = 0; kq < TOPK + 1; ++kq) { const float sk = sc[kq] * ys; ssum += sk;
#pragma unroll
                for (int j = 0; j < 4; ++j) { const unsigned w = v[kq][j];
                    a[j][0] += sk * (float)(w & 0xffu); a[j][1] += sk * (float)((w >> 8) & 0xffu); a[j][2] += sk * (float)((w >> 16) & 0xffu); a[j][3] += sk * (float)(w >> 24); } }
            { const float off = 128.f * ssum;
#pragma unroll
              for (int j = 0; j < 4; ++j) a[j] = a[j] - off; }
#pragma unroll
            for (int j = 0; j < 4; ++j) *(f32x4*)(o + 4 * j) = a[j];
        }
        if (PROBE == 9 && rep == 0) { asm volatile("s_waitcnt vmcnt(0)" ::: "memory"); __syncthreads(); }
        }
    }
}

extern "C" void kernel_launch(void* const* d_in, const int* in_sizes, int n_in, void* d_out, int out_size, void* d_ws, size_t ws_size, hipStream_t stream) {
    static int grid = 0;
    if (grid == 0) {
        int dev = 0, cus = 0, per_cu = 0;
        (void)hipGetDevice(&dev); (void)hipDeviceGetAttribute(&cus, hipDeviceAttributeMultiprocessorCount, dev);
        (void)hipFuncSetAttribute((const void*)mk_fwd, hipFuncAttributeMaxDynamicSharedMemorySize, LDS_BYTES);
        (void)hipOccupancyMaxActiveBlocksPerMultiprocessor(&per_cu, (const void*)mk_fwd, NTHR, LDS_BYTES);
        (void)hipGetLastError();
        grid = cus > 0 ? cus : 256;
    }
    Params p{};
    const float** pp = (const float**)&p;
    for (int i = 0; i < 22; ++i) pp[i] = (const float*)d_in[i];
    p.out = (float*)d_out; p.ws = (unsigned char*)d_ws;
    (void)hipMemsetAsync((char*)d_ws + WS_CTL, 0, CTL_BYTES, stream);
    hipLaunchKernelGGL(mk_fwd, dim3(grid), dim3(NTHR), LDS_BYTES, stream, p);
}
```

```cpp
#include <hip/hip_runtime.h>
#include <stdint.h>

#ifndef PROBE
#define PROBE 0
#endif
#define REPS(k) ((PROBE == (k)) ? 2 : 1)
#define LAS __attribute__((address_space(3)))
typedef unsigned short bf16;
typedef short bf16x8 __attribute__((ext_vector_type(8)));
typedef float f32x4 __attribute__((ext_vector_type(4)));
typedef unsigned u32x2 __attribute__((ext_vector_type(2)));
typedef unsigned u32x4 __attribute__((ext_vector_type(4)));

constexpr int S = 16384, D = 1024, DIN = 4608, DC = 512, NH = 8, HD = 64, GW = 64, ROWS = 256;
constexpr int NE = 64, TOPK = 8, NG = 8, TOPG = 4, DE = 256;
constexpr float EPS = 1e-6f, ROUTE_SCALE = 2.5f;
constexpr int MAXT = 576;
constexpr int MAXSLOT = MAXT * 256;
constexpr int NTHR = 512, NWAVES = 8;
constexpr float WGU_SC = 64.f, WD_SC = 32.f, Y_SC = 16.f;

constexpr size_t MiB = 1u << 20;
constexpr size_t WS_CTL = 0;
constexpr size_t CTL_BYTES = 65536;
constexpr size_t WS_WIN = 1 * MiB;
constexpr size_t WS_WCAT = 10 * MiB;
constexpr size_t WS_WO = 12 * MiB;
constexpr size_t WS_WRH = 14 * MiB;
constexpr size_t WS_WRL = 14 * MiB + 256 * 1024;
constexpr size_t WS_H = 16 * MiB;
constexpr size_t WS_U2 = 16 * MiB;
constexpr size_t WS_AO = 16 * MiB;
constexpr size_t WS_K = 48 * MiB;
constexpr size_t WS_VT = 64 * MiB;
constexpr size_t WS_MRG = 48 * MiB;
constexpr size_t WS_WGU = 80 * MiB;
constexpr size_t WS_SGA = 146 * MiB;
constexpr size_t WS_SGB = 178 * MiB;
constexpr size_t WS_Q = 210 * MiB;
constexpr size_t WS_HMID = 146 * MiB;
constexpr size_t WS_TIDX = 226 * MiB;
constexpr size_t WS_TW = 227 * MiB;
constexpr size_t WS_STOK = 228 * MiB;
constexpr size_t WS_SW = 229 * MiB;
constexpr size_t WS_TSLOT = 230 * MiB;
constexpr size_t WS_SRS = 231 * MiB;
constexpr size_t WS_CNTB = 232 * MiB;
constexpr size_t WS_WD = 236 * MiB;
constexpr size_t WS_U = 269 * MiB;
constexpr size_t WS_Y = 1 * MiB;
constexpr size_t WS_YSH = 269 * MiB;
constexpr size_t WS_YSC = 233 * MiB;
constexpr size_t WS_END = 285 * MiB;

constexpr int C_XN = 8000, C_XL = 8192;
constexpr int C_CUR2 = 3000; constexpr int C_CNT = 0, C_CUR = 64, C_PADSTART = 128, C_NT = 200, C_TEXP = 256, CW_BAR = 4096;
constexpr int LDS_BYTES = 163840, LDS_CTL_OFF = 159744, WSCR_BYTES = 17408;
constexpr int AUX_OFF = 131072;

struct Params {
    const float *x, *norm_mix_g, *w_in, *q_norm_g, *k_norm_g, *rpb, *conv_w, *conv_b, *ln_g, *ln_b, *w_conv_out, *w_attn_out, *w_o,
        *norm_ffn_g, *w_router, *router_bias, *w_eg, *w_eu, *w_ed, *w_sg, *w_su, *w_sd;
    float* out; unsigned char* ws;
};

__device__ __forceinline__ unsigned f2bf(float f) { unsigned u = __float_as_uint(f); return (u + 0x7fffu + ((u >> 16) & 1u)) >> 16; }
__device__ __forceinline__ float bf2f(unsigned h) { return __uint_as_float(h << 16); }
typedef __bf16 bf16x2_t __attribute__((ext_vector_type(2)));
typedef float f32x2_t __attribute__((ext_vector_type(2)));
__device__ __forceinline__ unsigned pk2(float lo, float hi) { f32x2_t f = {lo, hi}; bf16x2_t b = __builtin_convertvector(f, bf16x2_t); return __builtin_bit_cast(unsigned, b); }
typedef int i32x4_t __attribute__((ext_vector_type(4)));
typedef int i32x8_t __attribute__((ext_vector_type(8)));
__device__ __forceinline__ unsigned pk4f8(float a, float b, float c, float d) { int w = 0; w = __builtin_amdgcn_cvt_pk_fp8_f32(a, b, w, false); w = __builtin_amdgcn_cvt_pk_fp8_f32(c, d, w, true); return (unsigned)w; }
__device__ __forceinline__ float cl8(float v) { return __builtin_amdgcn_fmed3f(v, -448.f, 448.f); }
__device__ __forceinline__ unsigned pk4f8c(float a, float b, float c, float d) { return pk4f8(cl8(a), cl8(b), cl8(c), cl8(d)); }
__device__ __forceinline__ float sigmoidf_(float v) { return 1.f / (1.f + __expf(-v)); }
__device__ __forceinline__ int ldc(const int* p) { return __hip_atomic_load(p, __ATOMIC_RELAXED, __HIP_MEMORY_SCOPE_AGENT); }
__device__ __forceinline__ float wave_sum(float v) {
#define WS_DPP(x, ctrl) __uint_as_float((unsigned)__builtin_amdgcn_update_dpp(0, (int)__float_as_uint(x), ctrl, 0xf, 0xf, true))
    v += WS_DPP(v, 0xB1); v += WS_DPP(v, 0x4E); v += WS_DPP(v, 0x141); v += WS_DPP(v, 0x140);
#undef WS_DPP
    const int iv = (int)__float_as_uint(v);
    const float r0 = __uint_as_float((unsigned)__builtin_amdgcn_readlane(iv, 0)), r1 = __uint_as_float((unsigned)__builtin_amdgcn_readlane(iv, 16)),
                r2 = __uint_as_float((unsigned)__builtin_amdgcn_readlane(iv, 32)), r3 = __uint_as_float((unsigned)__builtin_amdgcn_readlane(iv, 48));
    return (r0 + r1) + (r2 + r3);
}

#define XB_TMO      128
#define XB_XCNT(j)  (256  + 64 * (j))
#define XB_XSUB(j)  (1280 + 64 * (j))
#define XB_XGEN(j)  (2304 + 64 * (j))
#define XB_TOP      3328
#define XB_TOPGEN   3392
#define XCD_BAR_WORDS 3456
#define XB_SPIN_CAP (1u << 18)
__device__ __forceinline__ unsigned xb_ld(unsigned* p)              { return __hip_atomic_load(p, __ATOMIC_RELAXED, __HIP_MEMORY_SCOPE_AGENT); }
__device__ __forceinline__ unsigned xb_add(unsigned* p, unsigned v) { return __hip_atomic_fetch_add(p, v, __ATOMIC_RELAXED, __HIP_MEMORY_SCOPE_AGENT); }
__device__ __forceinline__ unsigned xb_xcc_id() { return (unsigned)__builtin_amdgcn_s_getreg((3 << 11) | 20) & 0xFu; }
#define XB_SPIN(cond, bar) do { unsigned _sp = 0; while (cond) { __builtin_amdgcn_s_sleep(1); \
    if ((++_sp & 255u) == 0u) { if (xb_ld(&(bar)[XB_TMO])) break; if (_sp > XB_SPIN_CAP) { atomicAdd(&(bar)[XB_TMO], 1u); break; } } } } while (0)
struct XcdBarrier { unsigned* bar; unsigned x; volatile LAS unsigned* st; };
__device__ __forceinline__ XcdBarrier xcd_barrier_post(unsigned* bar, volatile LAS unsigned* st, bool leader) {
    XcdBarrier b; b.bar = bar; b.x = xb_xcc_id(); b.st = st;
    if (leader) (void)xb_add(&bar[XB_XCNT(b.x)], 1u);
    return b;
}
__device__ __forceinline__ void xcd_barrier_complete(unsigned* bar, unsigned x, unsigned& nloc, unsigned& nx) {
    const unsigned G = gridDim.x * gridDim.y * gridDim.z;
    unsigned sum, cnt, mine, sp = 0u;
    for (;;) {
        sum = 0u; cnt = 0u; mine = 0u;
#pragma unroll
        for (unsigned j = 0; j < 16; ++j) { const unsigned c = xb_ld(&bar[XB_XCNT(j)]); sum += c; cnt += (c > 0u) ? 1u : 0u; mine = (j == x) ? c : mine; }
        if (sum == G) break;
        __builtin_amdgcn_s_sleep(1);
        if ((++sp & 255u) == 0u) { if (xb_ld(&bar[XB_TMO])) break; if (sp > XB_SPIN_CAP) { atomicAdd(&bar[XB_TMO], 1u); break; } }
    }
    nloc = mine > 0u ? mine : 1u; nx = cnt > 0u ? cnt : 1u;
}
__device__ __forceinline__ void xcd_barrier1(const XcdBarrier& b, bool leader) {
    asm volatile("s_waitcnt vmcnt(0)" ::: "memory");
    __syncthreads();
    if (leader) {
        unsigned* bar = b.bar;
        __builtin_amdgcn_s_waitcnt(0);
        unsigned nloc = b.st[0], nx = b.st[1];
        if (nloc == 0u) { xcd_barrier_complete(bar, b.x, nloc, nx); b.st[0] = nloc; b.st[1] = nx; }
        const unsigned old = xb_add(&bar[XB_XSUB(b.x)], 1u);
        const unsigned gen = old / nloc;
        if (old + 1u == (gen + 1u) * nloc) {
            __builtin_amdgcn_fence(__ATOMIC_RELEASE, "agent");
            asm volatile("s_waitcnt vmcnt(0)" ::: "memory");
            const unsigned og = xb_add(&bar[XB_TOP], 1u);
            const unsigned tg = og / nx;
            if (og + 1u == (tg + 1u) * nx) xb_add(&bar[XB_TOPGEN], 1u);
            else XB_SPIN(xb_ld(&bar[XB_TOPGEN]) == tg, bar);
            __builtin_amdgcn_fence(__ATOMIC_ACQUIRE, "agent");
            xb_add(&bar[XB_XGEN(b.x)], 1u);
            asm volatile("s_waitcnt vmcnt(0)" ::: "memory");
        } else {
            XB_SPIN(xb_ld(&bar[XB_XGEN(b.x)]) == gen, bar);
            __builtin_amdgcn_fence(__ATOMIC_ACQUIRE, "agent");
            asm volatile("s_waitcnt vmcnt(0)" ::: "memory");
        }
    }
    __syncthreads();
}

__device__ __forceinline__ void xcd_barrier_(const XcdBarrier& b, bool leader) { xcd_barrier1(b, leader); if (PROBE == 99) xcd_barrier1(b, leader); }
__device__ __forceinline__ int owid(int WID) { int w = WID; asm volatile("" : "+s"(w)); return w; }
__device__ __forceinline__ int otid(int WID) { int l; asm volatile("v_mbcnt_lo_u32_b32 %0, -1, 0\n\tv_mbcnt_hi_u32_b32 %0, -1, %0" : "=v"(l)); return owid(WID) * 64 + l; }
struct MapId { int off; __device__ __forceinline__ int operator()(int n) const { return off + n; } };
struct MapIn {
    __device__ __forceinline__ int operator()(int n) const {
        if (n < 512) return 256 * (n >> 7) + (n & 127);
        if (n < 1024) { const int c = n - 512; return 256 * (c >> 7) + 128 + (c & 127); }
        if (n < 2048) { const int base = n < 1536 ? 1024 : 1536, c = n - base, h = c >> 6, d = c & 63; return base + 256 * (h >> 2) + (d >> 5) * 128 + 32 * (h & 3) + (d & 31); }
        return n; } };
struct MapDown { __device__ __forceinline__ int operator()(int c) const { const int o = c & 255; return (c & ~255) + 128 * ((o >> 3) & 1) + 32 * (o >> 6) + 8 * ((o >> 4) & 3) + (o & 7); } };
struct MapGU { int up; __device__ __forceinline__ int operator()(int c) const { return 256 * (c >> 7) + 128 * up + (c & 127); } };
template <bool LO, bool F8 = false, class Map> __device__ __forceinline__ void transpose_item(const float* W, int K, int N, bf16* WT, int ldo, int kofs, const Map& map, const float* gk, float* scr, int item, int lane, float wsc = 1.f) {
    const int nblk = N / 64, kb = item / nblk, nb = item % nblk, k0 = 64 * kb, n0 = 64 * nb;
    const int kr = lane >> 4, n4 = (lane & 15) * 4;
#pragma unroll
    for (int i = 0; i < 16; ++i) { const int kk = kr + 4 * i; f32x4 v = __builtin_nontemporal_load((const f32x4*)(W + (size_t)(k0 + kk) * N + n0 + n4)); if (gk) v = v * gk[k0 + kk];
        *(f32x4*)(scr + kk * 64 + (n4 ^ (4 * ((kk >> 3) & 7)))) = v; }
    asm volatile("s_waitcnt lgkmcnt(0)" ::: "memory");
    const int c = lane & 7;
#pragma unroll
    for (int j = 0; j < 8; ++j) { const int n = (lane >> 3) + 8 * j; const float* sp = scr + (8 * c) * 64 + (n ^ (4 * c)); float f[8];
#pragma unroll
        for (int i = 0; i < 8; ++i) { f[i] = sp[i * 64]; if (LO) f[i] -= bf2f(pk2(f[i], 0.f) & 0xffffu); }
        if (F8) { u32x2 o; o.x = pk4f8(f[0] * wsc, f[1] * wsc, f[2] * wsc, f[3] * wsc); o.y = pk4f8(f[4] * wsc, f[5] * wsc, f[6] * wsc, f[7] * wsc);
            *(u32x2*)((unsigned char*)WT + (size_t)map(n0 + n) * ldo + kofs + k0 + 8 * c) = o; }
        else { u32x4 o; o.x = pk2(f[0], f[1]); o.y = pk2(f[2], f[3]); o.z = pk2(f[4], f[5]); o.w = pk2(f[6], f[7]);
            *(u32x4*)(WT + (size_t)map(n0 + n) * ldo + kofs + k0 + 8 * c) = o; } }
    asm volatile("s_waitcnt lgkmcnt(0)" ::: "memory");
}
template <bool F8 = false> __device__ __forceinline__ void rmsnorm_row(const float* xrow, const float* g, bf16* orow, int lane) {
    const f32x4* xr = (const f32x4*)xrow + lane; f32x4 v[4]; float s = 0.f;
#pragma unroll
    for (int j = 0; j < 4; ++j) { v[j] = __builtin_nontemporal_load(xr + 64 * j); s += (v[j].x * v[j].x + v[j].y * v[j].y) + (v[j].z * v[j].z + v[j].w * v[j].w); }
    const float rs = rsqrtf(wave_sum(s) * (1.f / D) + EPS);
    u32x2* o = (u32x2*)orow + lane; unsigned* o8 = (unsigned*)orow + lane;
#pragma unroll
    for (int j = 0; j < 4; ++j) { const f32x4 gg = ((const f32x4*)g)[lane + 64 * j];
        if (F8) o8[64 * j] = pk4f8c(v[j].x * rs * gg.x, v[j].y * rs * gg.y, v[j].z * rs * gg.z, v[j].w * rs * gg.w);
        else { u32x2 w2; w2.x = pk2(v[j].x * rs * gg.x, v[j].y * rs * gg.y); w2.y = pk2(v[j].z * rs * gg.z, v[j].w * rs * gg.w); o[64 * j] = w2; } }
}

template <class P> __device__ __forceinline__ void wave_gemm_acc(const P& p, int m0, int n0, int K, f32x4 (&acc)[4][4], int lane) {
    const int g = lane >> 4, li = lane & 15;
    const bf16* ap[4]; const bf16* bp[4];
#pragma unroll
    for (int i = 0; i < 4; ++i) { ap[i] = p.arow(m0 + 16 * i + li) + 8 * g; bp[i] = p.brow(n0 + 16 * i + li) + 8 * g; }
    for (int k0 = 0; k0 < K; k0 += 32) {
        bf16x8 a[4], b[4];
#pragma unroll
        for (int i = 0; i < 4; ++i) { a[i] = *(const bf16x8*)(ap[i] + k0); b[i] = *(const bf16x8*)(bp[i] + k0); }
#pragma unroll
        for (int i = 0; i < 4; ++i)
#pragma unroll
            for (int j = 0; j < 4; ++j) acc[i][j] = __builtin_amdgcn_mfma_f32_16x16x32_bf16(b[j], a[i], acc[i][j], 0, 0, 0);
    }
}
__device__ __forceinline__ void zero_acc(f32x4 (&acc)[4][4]) {
#pragma unroll
    for (int i = 0; i < 4; ++i)
#pragma unroll
        for (int j = 0; j < 4; ++j) acc[i][j] = (f32x4){0.f, 0.f, 0.f, 0.f};
}
struct RowMat { const bf16* a; int lda; const bf16* b; int ldb;
    __device__ __forceinline__ const bf16* arow(int m) const { return a + (size_t)m * lda; }
    __device__ __forceinline__ const bf16* brow(int n) const { return b + (size_t)n * ldb; } };

struct ProjMat { const bf16* h; const bf16* wt;
    __device__ __forceinline__ const bf16* arow(int m) const { return h + (size_t)m * D; }
    __device__ __forceinline__ const bf16* brow(int vn) const { int n = vn; if (vn < 1024) { const int i = vn >> 6, j = vn & 63; n = (j < 32) ? (32 * i + j) : (512 + 32 * i + (j - 32)); } return wt + (size_t)n * D; } };
__device__ __forceinline__ void proj_epi(const Params& p, int m0, int n0, f32x4 (&acc)[4][4], int lane) {
    bf16 *u = (bf16*)(p.ws + WS_U), *q = (bf16*)(p.ws + WS_Q), *k = (bf16*)(p.ws + WS_K), *vT = (bf16*)(p.ws + WS_VT), *sga = (bf16*)(p.ws + WS_SGA), *sgb = (bf16*)(p.ws + WS_SGB);
    const int g = lane >> 4, li = lane & 15, vt = n0 >> 6;
#pragma unroll
    for (int mt = 0; mt < 4; ++mt) {
        const int m = m0 + 16 * mt + li;
        if (vt < 16) {
#pragma unroll
            for (int nt = 0; nt < 2; ++nt) { f32x4 a = acc[mt][nt], gt = acc[mt][nt + 2]; u32x2 w;
                w.x = pk2(a.x * sigmoidf_(gt.x), a.y * sigmoidf_(gt.y)); w.y = pk2(a.z * sigmoidf_(gt.z), a.w * sigmoidf_(gt.w));
                *(u32x2*)(u + (size_t)m * DC + 32 * vt + 16 * nt + 4 * g) = w; }
        } else if (vt < 32) {
            const bool isq = vt < 24; const int hh = isq ? vt - 16 : vt - 24; float ss = 0.f;
#pragma unroll
            for (int nt = 0; nt < 4; ++nt) { f32x4 v = acc[mt][nt]; ss += (v.x * v.x + v.y * v.y) + (v.z * v.z + v.w * v.w); }
            ss += __shfl_xor(ss, 16); ss += __shfl_xor(ss, 32);
            const float rs = rsqrtf(ss * (1.f / 64.f) + EPS) * (isq ? 0.125f : 1.f);
            const float* gg = isq ? p.q_norm_g : p.k_norm_g; bf16* o = (isq ? q : k) + (size_t)m * 512 + hh * 64;
#pragma unroll
            for (int nt = 0; nt < 4; ++nt) { f32x4 v = acc[mt][nt]; const f32x4 gv = *(const f32x4*)(gg + 16 * nt + 4 * g); u32x2 w;
                w.x = pk2(v.x * rs * gv.x, v.y * rs * gv.y); w.y = pk2(v.z * rs * gv.z, v.w * rs * gv.w); *(u32x2*)(o + 16 * nt + 4 * g) = w; }
        } else if (vt < 40) {
            const int hh = vt - 32;
#pragma unroll
            for (int nt = 0; nt < 4; ++nt)
#pragma unroll
                for (int r = 0; r < 4; ++r) vT[(size_t)(hh * 64 + 16 * nt + 4 * g + r) * S + m] = (bf16)f2bf(acc[mt][nt][r]);
        } else {
            bf16* o = (vt < 56 ? sga + (size_t)m * D + (vt - 40) * 64 : sgb + (size_t)m * D + (vt - 56) * 64);
#pragma unroll
            for (int nt = 0; nt < 4; ++nt) { f32x4 v = acc[mt][nt]; u32x2 w; w.x = pk2(sigmoidf_(v.x), sigmoidf_(v.y)); w.y = pk2(sigmoidf_(v.z), sigmoidf_(v.w));
                *(u32x2*)(o + 16 * nt + 4 * g) = w; }
        }
    }
}

__device__ __forceinline__ void conv_phase(const Params& p, unsigned char* lds, int G, int WID) {
    const bf16* u = (const bf16*)(p.ws + WS_U); bf16* u2 = (bf16*)(p.ws + WS_U2);
    unsigned char* ut = lds; float* cv = (float*)(lds + 65536);
    const int tid = otid(WID), cp = tid & 255, half = tid >> 8, wave = tid >> 6, lane = tid & 63;
    float w0[31], w1[31];
#pragma unroll
    for (int j = 0; j < 31; ++j) { const float2 wv = *(const float2*)(p.conv_w + j * DC + 2 * cp); w0[j] = wv.x; w1[j] = wv.y; }
    const float2 bv = *(const float2*)(p.conv_b + 2 * cp);
    for (int rep = 0; rep < REPS(20); ++rep)
    for (int item = blockIdx.x; item < S / 32; item += G) {
        const int t0 = item * 32;
#pragma unroll
        for (int j = 0; j < 8; ++j) { const int pc = tid + 512 * j; if (pc < 62 * 64) { const int row = pc >> 6, c16 = pc & 63, tt = t0 - 15 + row; u32x4 v = (u32x4){0u, 0u, 0u, 0u};
            if (tt >= 0 && tt < S) v = *(const u32x4*)(u + (size_t)tt * DC + c16 * 8); *(u32x4*)(ut + row * 1024 + c16 * 16) = v; } }
        __syncthreads();
#pragma unroll 1
        for (int hp = 0; hp < 2; ++hp) {
            float a0[8], a1[8];
#pragma unroll
            for (int t = 0; t < 8; ++t) { a0[t] = bv.x; a1[t] = bv.y; }
            const unsigned char* up = ut + (half * 16 + hp * 8) * 1024 + 4 * cp;
#pragma unroll
            for (int i = 0; i < 38; ++i) { const unsigned v = *(const unsigned*)(up + i * 1024); const float x0 = bf2f(v & 0xffff), x1 = bf2f(v >> 16);
#pragma unroll
                for (int t = 0; t < 8; ++t) { const int j = i - t; if (j >= 0 && j < 31) { a0[t] += w0[j] * x0; a1[t] += w1[j] * x1; } } }
#pragma unroll
            for (int t = 0; t < 8; ++t) *(float2*)(cv + (half * 16 + hp * 8 + t) * DC + 2 * cp) = make_float2(a0[t], a1[t]);
        }
        __syncthreads();
#pragma unroll
        for (int q = 0; q < 4; ++q) {
            const int tl = wave * 4 + q; const float* row = cv + tl * DC;
            f32x4 v0 = *(const f32x4*)(row + 8 * lane), v1 = *(const f32x4*)(row + 8 * lane + 4);
            const float mean = wave_sum((v0.x + v0.y) + (v0.z + v0.w) + (v1.x + v1.y) + (v1.z + v1.w)) * (1.f / DC);
            v0 = v0 - mean; v1 = v1 - mean;
            const float var = wave_sum((v0.x * v0.x + v0.y * v0.y) + (v0.z * v0.z + v0.w * v0.w) + (v1.x * v1.x + v1.y * v1.y) + (v1.z * v1.z + v1.w * v1.w)) * (1.f / DC);
            const float rstd = rsqrtf(var + EPS);
            const f32x4 g0 = *(const f32x4*)(p.ln_g + 8 * lane), g1 = *(const f32x4*)(p.ln_g + 8 * lane + 4), b0 = *(const f32x4*)(p.ln_b + 8 * lane), b1 = *(const f32x4*)(p.ln_b + 8 * lane + 4);
            v0 = v0 * rstd * g0 + b0; v1 = v1 * rstd * g1 + b1;
            u32x4 w; w.x = pk2(v0.x * sigmoidf_(v0.x), v0.y * sigmoidf_(v0.y)); w.y = pk2(v0.z * sigmoidf_(v0.z), v0.w * sigmoidf_(v0.w));
            w.z = pk2(v1.x * sigmoidf_(v1.x), v1.y * sigmoidf_(v1.y)); w.w = pk2(v1.z * sigmoidf_(v1.z), v1.w * sigmoidf_(v1.w));
            *(u32x4*)(u2 + (size_t)(t0 + tl) * D + 8 * lane) = w;
        }
        __syncthreads();
    }
}

__device__ __forceinline__ void attn_wave(const bf16* q, const bf16* k, const bf16* vT, const float* rpb, bf16* ao, int r, int h, int qb, int lane) {
    const int g = lane >> 4, qi = lane & 15, c0 = 16 * qb, c = c0 + qi;
    int cs = c0 - 8; cs = cs < 0 ? 0 : (cs > 32 ? 32 : cs);
    int colst = c - 8; colst = colst < 0 ? 0 : (colst > 48 ? 48 : colst);
    int rs = r - 4; rs = rs < 0 ? 0 : (rs > ROWS - 8 ? ROWS - 8 : rs);
    const bf16* qp = q + (size_t)(r * 64 + c) * 512 + h * 64 + 8 * g;
    const bf16x8 bq0 = *(const bf16x8*)qp, bq1 = *(const bf16x8*)(qp + 32);
    const int kk = 8 * (qi >> 2) + (qi & 3);
    float sc[8][2][4]; float mx = -3.0e38f;
#pragma unroll
    for (int i = 0; i < 8; ++i) {
        const float* bias_row = rpb + (size_t)(h * 15 + (rs + i - r + 7)) * 31;
#pragma unroll
        for (int T = 0; T < 2; ++T) {
            const bf16* kp = k + (size_t)((rs + i) * 64 + cs + kk + 4 * T) * 512 + h * 64 + 8 * g;
            f32x4 acc = (f32x4){0.f, 0.f, 0.f, 0.f};
            acc = __builtin_amdgcn_mfma_f32_16x16x32_bf16(*(const bf16x8*)kp, bq0, acc, 0, 0, 0);
            acc = __builtin_amdgcn_mfma_f32_16x16x32_bf16(*(const bf16x8*)(kp + 32), bq1, acc, 0, 0, 0);
#pragma unroll
            for (int rr = 0; rr < 4; ++rr) {
                const int kc = cs + 8 * g + rr + 4 * T; const bool valid = (kc >= colst) && (kc < colst + 16);
                int bi = kc - c + 15; bi = bi < 0 ? 0 : (bi > 30 ? 30 : bi);
                const float s = valid ? acc[rr] + bias_row[bi] : -3.0e38f;
                sc[i][T][rr] = s; mx = fmaxf(mx, s);
            }
        }
    }
    mx = fmaxf(mx, __shfl_xor(mx, 16)); mx = fmaxf(mx, __shfl_xor(mx, 32));
    float sum = 0.f;
#pragma unroll
    for (int i = 0; i < 8; ++i)
#pragma unroll
        for (int T = 0; T < 2; ++T)
#pragma unroll
            for (int rr = 0; rr < 4; ++rr) { const float s = sc[i][T][rr]; const float e = (s > -1.0e38f) ? __expf(s - mx) : 0.f; sc[i][T][rr] = e; sum += e; }
    sum += __shfl_xor(sum, 16); sum += __shfl_xor(sum, 32);
    const float inv = 1.f / sum;
    f32x4 o[4];
#pragma unroll
    for (int n = 0; n < 4; ++n) o[n] = (f32x4){0.f, 0.f, 0.f, 0.f};
#pragma unroll
    for (int i = 0; i < 8; ++i) {
        union { bf16x8 v; unsigned w[4]; } pb;
        pb.w[0] = pk2(sc[i][0][0], sc[i][0][1]); pb.w[1] = pk2(sc[i][0][2], sc[i][0][3]); pb.w[2] = pk2(sc[i][1][0], sc[i][1][1]); pb.w[3] = pk2(sc[i][1][2], sc[i][1][3]);
#pragma unroll
        for (int n = 0; n < 4; ++n) {
            const bf16x8 av = *(const bf16x8*)(vT + (size_t)(h * 64 + 16 * n + qi) * S + (rs + i) * 64 + cs + 8 * g);
            o[n] = __builtin_amdgcn_mfma_f32_16x16x32_bf16(av, pb.v, o[n], 0, 0, 0);
        }
    }
    bf16* op = ao + (size_t)(r * 64 + c) * D + 512 + h * 64 + 4 * g;
#pragma unroll
    for (int n = 0; n < 4; ++n) { u32x2 w; w.x = pk2(o[n].x * inv, o[n].y * inv); w.y = pk2(o[n].z * inv, o[n].w * inv); *(u32x2*)(op + 16 * n) = w; }
}


__device__ __forceinline__ void attn_phase(const Params& p, unsigned char* lds, int G, int WID) {
    const bf16* q = (const bf16*)(p.ws + WS_Q); const bf16* kk_ = (const bf16*)(p.ws + WS_K); const bf16* vT = (const bf16*)(p.ws + WS_VT); bf16* ao = (bf16*)(p.ws + WS_AO);
    unsigned char* kr = lds; unsigned char* vr = lds + 65536; float* xch = (float*)(lds + 131072); float* bt = (float*)(lds + 131072 + 10240);
    const int tid = otid(WID), lane = tid & 63, wave = owid(WID), g = lane >> 4, qi = lane & 15, qb = wave & 3, kh = wave >> 2;
    const int srow = tid >> 3, sch = tid & 7;
    const int c0 = 16 * qb, c = c0 + qi;
    int cs = c0 - 8; cs = cs < 0 ? 0 : (cs > 32 ? 32 : cs);
    int colst = c - 8; colst = colst < 0 ? 0 : (colst > 48 ? 48 : colst);
    const int kcol = 8 * (qi >> 2) + (qi & 3);
    int bofs[2][4]; unsigned vmask = 0u;
#pragma unroll
    for (int T = 0; T < 2; ++T)
#pragma unroll
        for (int rr = 0; rr < 4; ++rr) { const int kc = cs + 8 * g + rr + 4 * T; if ((kc >= colst) && (kc < colst + 16)) vmask |= 1u << (4 * T + rr); int bi = kc - c + 15; bofs[T][rr] = bi < 0 ? 0 : (bi > 30 ? 30 : bi); }
    for (int unit = blockIdx.x; unit < NH * (ROWS / 8); unit += G) {
        const int h = unit & 7, r0 = (unit >> 3) * 8;
        __syncthreads();
        for (int i = tid; i < 15 * 31; i += NTHR) bt[i] = p.rpb[h * 465 + i] * 1.44269504089f;
        int rs0 = r0 - 4; rs0 = rs0 < 0 ? 0 : (rs0 > ROWS - 8 ? ROWS - 8 : rs0);
#pragma unroll
        for (int j = 0; j < 8; ++j) { const int krow = rs0 + j, sl = krow & 7;
            const u32x4 a = *(const u32x4*)(kk_ + (size_t)(krow * 64 + srow) * 512 + h * 64 + sch * 8), b = *(const u32x4*)(vT + (size_t)(h * 64 + srow) * S + krow * 64 + sch * 8);
            *(u32x4*)(kr + sl * 8192 + srow * 128 + ((sch ^ (srow & 7)) << 4)) = a; *(u32x4*)(vr + sl * 8192 + srow * 128 + ((sch ^ (srow & 7)) << 4)) = b; }
        __syncthreads();
        bf16x8 bq0, bq1;
        { const bf16* qp = q + (size_t)(r0 * 64 + c) * 512 + h * 64 + 8 * g; bq0 = *(const bf16x8*)qp; bq1 = *(const bf16x8*)(qp + 32); }
#pragma unroll 1
        for (int j = 0; j < 8; ++j) {
            const int r = r0 + j; int rs = r - 4; rs = rs < 0 ? 0 : (rs > ROWS - 8 ? ROWS - 8 : rs);
            int rsn = r + 1 - 4; rsn = rsn < 0 ? 0 : (rsn > ROWS - 8 ? ROWS - 8 : rsn);
            const bool pf = (j < 7) && (rsn != rs);
            u32x4 pa = (u32x4){0u, 0u, 0u, 0u}, pb = pa;
            if (pf) { const int krow = rsn + 7; pa = *(const u32x4*)(kk_ + (size_t)(krow * 64 + srow) * 512 + h * 64 + sch * 8); pb = *(const u32x4*)(vT + (size_t)(h * 64 + srow) * S + krow * 64 + sch * 8); }
            bf16x8 nq0 = bq0, nq1 = bq1;
            if (j < 7) { const bf16* qp = q + (size_t)((r + 1) * 64 + c) * 512 + h * 64 + 8 * g; nq0 = *(const bf16x8*)qp; nq1 = *(const bf16x8*)(qp + 32); }
            float sc[4][2][4]; float mx = -3.0e38f;
#pragma unroll
            for (int i4 = 0; i4 < 4; ++i4) {
                const int i = 4 * kh + i4, sl = (rs + i) & 7; const float* brow = bt + (rs + i - r + 7) * 31;
#pragma unroll
                for (int T = 0; T < 2; ++T) {
                    const int col = cs + kcol + 4 * T; const unsigned char* kp = kr + sl * 8192 + col * 128;
                    const bf16x8 k0 = *(const bf16x8*)(kp + (((g) ^ (col & 7)) << 4)), k1 = *(const bf16x8*)(kp + (((4 + g) ^ (col & 7)) << 4));
                    f32x4 acc = (f32x4){0.f, 0.f, 0.f, 0.f};
                    acc = __builtin_amdgcn_mfma_f32_16x16x32_bf16(k0, bq0, acc, 0, 0, 0);
                    acc = __builtin_amdgcn_mfma_f32_16x16x32_bf16(k1, bq1, acc, 0, 0, 0);
#pragma unroll
                    for (int rr = 0; rr < 4; ++rr) {
                        const float sv = ((vmask >> (4 * T + rr)) & 1u) ? acc[rr] + brow[bofs[T][rr]] : -3.0e38f;
                        sc[i4][T][rr] = sv; mx = fmaxf(mx, sv);
                    }
                }
            }
            mx = fmaxf(mx, __shfl_xor(mx, 16)); mx = fmaxf(mx, __shfl_xor(mx, 32));
            float sum = 0.f;
#pragma unroll
            for (int i4 = 0; i4 < 4; ++i4)
#pragma unroll
                for (int T = 0; T < 2; ++T)
#pragma unroll
                    for (int rr = 0; rr < 4; ++rr) { const float e = __builtin_amdgcn_exp2f(sc[i4][T][rr] - mx); sc[i4][T][rr] = e; sum += e; }
            sum += __shfl_xor(sum, 16); sum += __shfl_xor(sum, 32);
            f32x4 o[4];
#pragma unroll
            for (int n = 0; n < 4; ++n) o[n] = (f32x4){0.f, 0.f, 0.f, 0.f};
#pragma unroll
            for (int i4 = 0; i4 < 4; ++i4) {
                const int sl = (rs + 4 * kh + i4) & 7;
                union { bf16x8 v; unsigned w[4]; } pb2;
                pb2.w[0] = pk2(sc[i4][0][0], sc[i4][0][1]); pb2.w[1] = pk2(sc[i4][0][2], sc[i4][0][3]); pb2.w[2] = pk2(sc[i4][1][0], sc[i4][1][1]); pb2.w[3] = pk2(sc[i4][1][2], sc[i4][1][3]);
#pragma unroll
                for (int n = 0; n < 4; ++n) { const int d = 16 * n + qi;
                    const bf16x8 av = *(const bf16x8*)(vr + sl * 8192 + d * 128 + ((((cs >> 3) + g) ^ (d & 7)) << 4));
                    o[n] = __builtin_amdgcn_mfma_f32_16x16x32_bf16(av, pb2.v, o[n], 0, 0, 0); }
            }
            if (kh == 1) {
                float* x = xch + qb * 640 + lane; x[0] = mx; x[64] = sum;
#pragma unroll
                for (int n = 0; n < 4; ++n) { x[(2 + 2 * n) * 64] = __uint_as_float(pk2(o[n][0], o[n][1])); x[(3 + 2 * n) * 64] = __uint_as_float(pk2(o[n][2], o[n][3])); }
            }
            __syncthreads();
            if (pf) { const int sl = (rsn + 7) & 7; *(u32x4*)(kr + sl * 8192 + srow * 128 + ((sch ^ (srow & 7)) << 4)) = pa; *(u32x4*)(vr + sl * 8192 + srow * 128 + ((sch ^ (srow & 7)) << 4)) = pb; }
            if (kh == 0) {
                const float* x = xch + qb * 640 + lane; const float mB = x[0], lB = x[64];
                const float m = fmaxf(mx, mB), fa = __builtin_amdgcn_exp2f(mx - m), fb = __builtin_amdgcn_exp2f(mB - m), inv = 1.f / (sum * fa + lB * fb);
                bf16* op = ao + (size_t)(r * 64 + c) * D + 512 + h * 64 + 4 * g;
#pragma unroll
                for (int n = 0; n < 4; ++n) { const unsigned w0 = __float_as_uint(x[(2 + 2 * n) * 64]), w1 = __float_as_uint(x[(3 + 2 * n) * 64]);
                    const float v0 = (o[n][0] * fa + bf2f(w0 & 0xffff) * fb) * inv, v1 = (o[n][1] * fa + bf2f(w0 >> 16) * fb) * inv, v2 = (o[n][2] * fa + bf2f(w1 & 0xffff) * fb) * inv, v3 = (o[n][3] * fa + bf2f(w1 >> 16) * fb) * inv;
                    u32x2 w; w.x = pk2(v0, v1); w.y = pk2(v2, v3); *(u32x2*)(op + 16 * n) = w; }
            }
            __syncthreads();
            bq0 = nq0; bq1 = nq1;
        }
    }
}


namespace pg8 {
constexpr int BM = 256, BK = 64, HALF = 128, HTB = HALF * BK * 2;
__device__ __forceinline__ int lds_byte(int r, int c) { const int st = (r >> 4) * 2 + (c >> 5), rr = r & 15, cc = c & 31, ob = rr * 64 + cc * 2; return st * 1024 + (ob ^ (((ob >> 9) & 1) << 5)); }
__device__ __forceinline__ void stage_rc(int b, int& R, int& C) { const int st = b / 1024, sb = b % 1024, swz = sb ^ (((sb >> 9) & 1) << 5); R = (st >> 1) * 16 + swz / 64; C = (st & 1) * 32 + (swz % 64) / 2; }
__device__ __forceinline__ int perm32(int rho) { const int n = rho >> 4, i = rho & 15; return 8 * (i >> 2) + 4 * n + (i & 3); }
__device__ __forceinline__ unsigned cvt_pk_bf16(float lo, float hi) { return pk2(lo, hi); }
struct Unit { int pm, pn, e, slot; };
typedef f32x4 Acc[2][2][4][2];

__device__ __forceinline__ i32x8_t cat8(bf16x8 a, bf16x8 b) { return __builtin_shufflevector(__builtin_bit_cast(i32x4_t, a), __builtin_bit_cast(i32x4_t, b), 0, 1, 2, 3, 4, 5, 6, 7); }
template <class Epi, class Sched, bool ALIGN_EPI, int F8SH = -1>
__device__ __forceinline__ void gemm_phase(LAS unsigned char* lds, const char* A, int K, const Sched& S, const Epi& E, int WID) {
    constexpr bool F8 = F8SH >= 0;
    int tid_ = otid(WID);
    const int tid = tid_, wid = owid(WID), lane = tid & 63, wr = wid >> 2, wc = wid & 3, fr = lane & 15, fq = lane >> 4;
    const int nt = K / BK;
    unsigned voffB[2];
#pragma unroll
    for (int i = 0; i < 2; ++i) { int R, C; stage_rc(tid * 16 + i * 8192, R, C); const int Rb = (R & ~31) + perm32(R & 31); voffB[i] = (unsigned)(Rb * K + C) * 2u; }
#define PG8_AOFFS(un, o00, o01, o10, o11) do { int t2_ = tid; asm volatile("" : "+v"(t2_)); int R0_, C0_, R1_, C1_; stage_rc(t2_ * 16, R0_, C0_); stage_rc(t2_ * 16 + 8192, R1_, C1_); const unsigned ko_ = S.a_koff(un); \
        o00 = S.a_off(un, R0_) + ko_ + (unsigned)C0_ * 2u; o01 = S.a_off(un, R1_) + ko_ + (unsigned)C1_ * 2u; o10 = S.a_off(un, HALF + R0_) + ko_ + (unsigned)C0_ * 2u; o11 = S.a_off(un, HALF + R1_) + ko_ + (unsigned)C1_ * 2u; } while (0)
    const size_t kstep = (size_t)(BK * 2);
    const size_t hstepB = (size_t)HALF * K * 2;
    const unsigned ldsw = (unsigned)wid * 1024u;
    const int aoff = lds_byte(wr * 64 + fr, fq * 8), boff = lds_byte(wc * 32 + fr, fq * 8);
#define PG8_SA(b, h) (((b) * 2 + (h)) * HTB)
#define PG8_SB(b, h) ((4 + (b) * 2 + (h)) * HTB)
#define PG8_STAGE(bufoff, gbase, v0, v1) do { \
        __builtin_amdgcn_global_load_lds((const unsigned*)((const char*)(gbase) + (v0)), (LAS unsigned*)(lds + (bufoff) + ldsw), 16, 0, 0); \
        __builtin_amdgcn_global_load_lds((const unsigned*)((const char*)(gbase) + (v1)), (LAS unsigned*)(lds + (bufoff) + ldsw + 8192), 16, 0, 0); } while (0)
#define PG8_LDA(dst, b, h) do { _Pragma("unroll") for (int m = 0; m < 4; ++m) _Pragma("unroll") for (int k = 0; k < 2; ++k) dst[m][k] = *(const LAS bf16x8*)(lds + PG8_SA(b, h) + aoff + m * 2048 + k * 1024); } while (0)
#define PG8_LDB(dst, b, h) do { _Pragma("unroll") for (int n = 0; n < 2; ++n) _Pragma("unroll") for (int k = 0; k < 2; ++k) dst[n][k] = *(const LAS bf16x8*)(lds + PG8_SB(b, h) + boff + n * 2048 + k * 1024); } while (0)
#define PG8_MMA(ai, bj, At, Bt) do { __builtin_amdgcn_s_setprio(1); _Pragma("unroll") for (int m = 0; m < 4; ++m) _Pragma("unroll") for (int n = 0; n < 2; ++n) { \
        if (F8) acc[ai][bj][m][n] = __builtin_amdgcn_mfma_scale_f32_16x16x128_f8f6f4(cat8(Bt[n][0], Bt[n][1]), cat8(At[m][0], At[m][1]), acc[ai][bj][m][n], 0, 0, 0, 0, 0, 0); \
        else { _Pragma("unroll") for (int k = 0; k < 2; ++k) acc[ai][bj][m][n] = __builtin_amdgcn_mfma_f32_16x16x32_bf16(Bt[n][k], At[m][k], acc[ai][bj][m][n], 0, 0, 0); } } __builtin_amdgcn_s_setprio(0); } while (0)
#define PG8_WAIT_V(n) asm volatile("s_waitcnt vmcnt(" #n ")" ::: "memory")
#define PG8_WAIT_L(n) asm volatile("s_waitcnt lgkmcnt(" #n ")" ::: "memory")
#define PG8_WAIT_VR(rl) do { if (rl) asm volatile("s_waitcnt vmcnt(%0)" :: "i"(8 + Epi::MIN_STORES) : "memory"); else asm volatile("s_waitcnt vmcnt(8)" ::: "memory"); } while (0)
#define PG8_BAR __builtin_amdgcn_s_barrier()
#define PG8_SCHED __builtin_amdgcn_sched_barrier(0)
#define PG8_ZERO() do { _Pragma("unroll") for (int a = 0; a < 2; ++a) _Pragma("unroll") for (int b = 0; b < 2; ++b) _Pragma("unroll") for (int m = 0; m < 4; ++m) _Pragma("unroll") for (int n = 0; n < 2; ++n) acc[a][b][m][n] = (f32x4){0.f, 0.f, 0.f, 0.f}; } while (0)
    __builtin_amdgcn_sched_barrier(0);
    Unit cur, nxt; int ui = 0;
    if (!S.next(0, cur)) return;
    Acc acc; PG8_ZERO();
    bf16x8 At[4][2], B0[2][2], B1[2][2];
    unsigned c00, c01, c10, c11, n00, n01, n10, n11;
    PG8_AOFFS(cur, c00, c01, c10, c11);
    const char* cB = S.b_ptr(cur);
    PG8_STAGE(PG8_SB(0, 0), cB, voffB[0], voffB[1]); PG8_STAGE(PG8_SB(0, 1), cB + hstepB, voffB[0], voffB[1]); PG8_STAGE(PG8_SA(0, 0), A, c00, c01); PG8_STAGE(PG8_SA(0, 1), A, c10, c11);
    if (wr == 1) PG8_BAR;
    PG8_WAIT_V(2); PG8_BAR;
    PG8_STAGE(PG8_SB(1, 0), cB + kstep, voffB[0], voffB[1]); PG8_STAGE(PG8_SA(1, 0), A + kstep, c00, c01); PG8_STAGE(PG8_SB(1, 1), cB + hstepB + kstep, voffB[0], voffB[1]);
    PG8_WAIT_V(6); PG8_BAR;
    for (;;) {
        const bool has_next = S.next(ui + 1, nxt);
        const char* nB = cB; n00 = c00; n01 = c01; n10 = c10; n11 = c11;
        if (has_next) { PG8_AOFFS(nxt, n00, n01, n10, n11); nB = S.b_ptr(nxt); }
#define PG8_KBODY(t, last, rlx) do { \
            const char* a1 = A + (size_t)(t + 1) * kstep; \
            const char* a2 = last ? A : A + (size_t)(t + 2) * kstep; const char* b2 = last ? nB : cB + (size_t)(t + 2) * kstep; \
            const char* a3 = a2 + kstep; const char* b3 = b2 + kstep; \
            const unsigned s00 = last ? n00 : c00, s01 = last ? n01 : c01, s10 = last ? n10 : c10, s11 = last ? n11 : c11; \
            PG8_LDB(B0, 0, 0); PG8_LDB(B1, 0, 1); PG8_SCHED; PG8_LDA(At, 0, 0); PG8_STAGE(PG8_SA(1, 1), a1, c10, c11); \
            PG8_WAIT_VR(rlx); PG8_WAIT_L(0); PG8_BAR; PG8_MMA(0, 0, At, B0); PG8_MMA(0, 1, At, B1); PG8_BAR; PG8_SCHED; \
            PG8_LDA(At, 0, 1); PG8_STAGE(PG8_SB(0, 0), b2, voffB[0], voffB[1]); PG8_STAGE(PG8_SB(0, 1), b2 + hstepB, voffB[0], voffB[1]); PG8_STAGE(PG8_SA(0, 0), a2, s00, s01); \
            PG8_WAIT_VR(rlx); PG8_WAIT_L(0); PG8_BAR; PG8_MMA(1, 0, At, B0); PG8_MMA(1, 1, At, B1); PG8_BAR; PG8_SCHED; \
            PG8_LDB(B0, 1, 0); PG8_LDB(B1, 1, 1); PG8_SCHED; PG8_LDA(At, 1, 0); PG8_STAGE(PG8_SA(0, 1), a2, s10, s11); \
            PG8_WAIT_V(8); PG8_WAIT_L(0); PG8_BAR; PG8_MMA(0, 0, At, B0); PG8_MMA(0, 1, At, B1); PG8_BAR; PG8_SCHED; \
            PG8_LDA(At, 1, 1); PG8_STAGE(PG8_SB(1, 0), b3, voffB[0], voffB[1]); PG8_STAGE(PG8_SB(1, 1), b3 + hstepB, voffB[0], voffB[1]); PG8_STAGE(PG8_SA(1, 0), a3, s00, s01); \
            PG8_WAIT_V(8); PG8_WAIT_L(0); PG8_BAR; PG8_MMA(1, 0, At, B0); PG8_MMA(1, 1, At, B1); PG8_BAR; PG8_SCHED; \
        } while (0)
        if (Epi::HAS_MID) {
            _Pragma("unroll 1") for (int t = 0; t < nt / 2; t += 2) { const bool rl = (ui > 0) && (t == 0); PG8_KBODY(t, false, rl); }
            E.mid(acc, cur, wr, wc, fr, fq);
            _Pragma("unroll 1") for (int t = nt / 2; t < nt; t += 2) { const bool lastq = (t == nt - 2); PG8_KBODY(t, lastq, false); }
        } else {
            _Pragma("unroll 1") for (int t = 0; t < nt; t += 2) { const bool lastq = (t == nt - 2), rl = (ui > 0) && (t == 0); PG8_KBODY(t, lastq, rl); }
        }
#undef PG8_KBODY
        if (ALIGN_EPI) { if (wr == 0) PG8_BAR; }
        if (F8 && F8SH > 0) { constexpr float asc = 1.f / (float)(1 << (F8SH > 0 ? F8SH : 0));
            _Pragma("unroll") for (int a = 0; a < 2; ++a) _Pragma("unroll") for (int b = 0; b < 2; ++b) _Pragma("unroll") for (int m = 0; m < 4; ++m) _Pragma("unroll") for (int n = 0; n < 2; ++n) acc[a][b][m][n] = acc[a][b][m][n] * asc; }
        { int t3 = tid; asm volatile("" : "+v"(t3)); const int l3 = t3 & 63; E(acc, cur, wr, wc, l3 & 15, l3 >> 4); }
        if (!has_next) break;
        PG8_ZERO();
        cur = nxt; cB = nB; c00 = n00; c01 = n01; c10 = n10; c11 = n11; ++ui;
        if (ALIGN_EPI) { if (wr == 1) PG8_BAR; }
    }
    PG8_WAIT_V(0);
    if (!ALIGN_EPI) { if (wr == 0) PG8_BAR; }
    PG8_BAR;
#undef PG8_SA
#undef PG8_SB
#undef PG8_STAGE
#undef PG8_LDA
#undef PG8_LDB
#undef PG8_MMA
#undef PG8_WAIT_V
#undef PG8_WAIT_L
#undef PG8_WAIT_VR
#undef PG8_BAR
#undef PG8_SCHED
#undef PG8_ZERO
#undef PG8_AOFFS
}
struct DenseOrder {
    int nM, nN, nwg, G, c; unsigned lda2; const char* Bt; size_t btile;
    __device__ __forceinline__ void init(int M, int N, int K, int lda, const void* Bt_, int G_, int c_) { nM = M / BM; nN = N / BM; nwg = nM * nN; G = G_; c = c_; lda2 = (unsigned)lda * 2u; Bt = (const char*)Bt_; btile = (size_t)BM * K * 2; }
    __device__ __forceinline__ bool next(int i, Unit& u) const {
        const long L = (long)i * G + c; if (L >= nwg) return false;
        int wgid = (int)L; { const int q = nwg / 8, r = nwg % 8, xcd = wgid % 8, off = wgid / 8; wgid = (xcd < r ? xcd * (q + 1) : r * (q + 1) + (xcd - r) * q) + off; }
        const int nig = 8 * nN, gid = wgid / nig, fm = gid * 8, gsz = (nM - fm) < 8 ? (nM - fm) : 8;
        u.pm = fm + ((wgid % nig) % gsz); u.pn = (wgid % nig) / gsz; u.e = 0; u.slot = 0; return true;
    }
    __device__ __forceinline__ unsigned a_off(const Unit& u, int r) const { return (unsigned)(u.pm * BM + r) * lda2; }
    __device__ __forceinline__ unsigned a_koff(const Unit&) const { return 0u; }
    __device__ __forceinline__ const char* b_ptr(const Unit& u) const { return Bt + (size_t)u.pn * btile; }
};
struct EpiResid {
    static constexpr bool HAS_MID = false; static constexpr int MIN_STORES = 0;
    const float* __restrict__ x; float* __restrict__ out; unsigned char* __restrict__ xq;
    __device__ __forceinline__ void mid(Acc&, const Unit&, int, int, int, int) const {}
    __device__ __forceinline__ void operator()(const Acc& acc, const Unit& u, int wr, int wc, int fr, int fq) const {
        const int row0 = u.pm * BM + wr * 64 + fr, col0 = u.pn * BM + wc * 32 + 8 * fq;
#pragma unroll
        for (int ai = 0; ai < 2; ++ai)
#pragma unroll
            for (int m = 0; m < 4; ++m) { const size_t ro = (size_t)(row0 + ai * HALF + m * 16) * D + col0;
                f32x4 xv[2][2];
#pragma unroll
                for (int bj = 0; bj < 2; ++bj)
#pragma unroll
                    for (int n = 0; n < 2; ++n) xv[bj][n] = __builtin_nontemporal_load((const f32x4*)(x + ro + bj * HALF + 4 * n));
#pragma unroll
                for (int bj = 0; bj < 2; ++bj) { const f32x4 v0 = xv[bj][0] + acc[ai][bj][m][0], v1 = xv[bj][1] + acc[ai][bj][m][1];
                    *(f32x4*)(out + ro + bj * HALF) = v0; *(f32x4*)(out + ro + bj * HALF + 4) = v1;
                    u32x2 w; w.x = pk4f8c(v0[0], v0[1], v0[2], v0[3]); w.y = pk4f8c(v1[0], v1[1], v1[2], v1[3]);
                    *(u32x2*)(xq + ro + bj * HALF) = w; } }
    }
};
__device__ __forceinline__ float sigm(float v) { return __builtin_amdgcn_rcpf(1.f + __expf(-v)); }
struct EpiProj {
    static constexpr bool HAS_MID = false; static constexpr int MIN_STORES = 8;
    bf16 *u, *q, *k, *vT, *sga, *sgb; const float *qg, *kg;
    __device__ __forceinline__ void mid(Acc&, const Unit&, int, int, int, int) const {}
    __device__ __forceinline__ void operator()(const Acc& acc, const Unit& un, int wr, int wc, int fr, int fq) const {
        const int row0 = un.pm * BM + wr * 64 + fr, pn = un.pn;
        if (pn < 4) {
#pragma unroll
            for (int ai = 0; ai < 2; ++ai)
#pragma unroll
                for (int m = 0; m < 4; ++m) { const f32x4 a0 = acc[ai][0][m][0], a1 = acc[ai][0][m][1], g0 = acc[ai][1][m][0], g1 = acc[ai][1][m][1]; u32x4 w;
                    w.x = cvt_pk_bf16(a0[0] * sigm(g0[0]), a0[1] * sigm(g0[1])); w.y = cvt_pk_bf16(a0[2] * sigm(g0[2]), a0[3] * sigm(g0[3]));
                    w.z = cvt_pk_bf16(a1[0] * sigm(g1[0]), a1[1] * sigm(g1[1])); w.w = cvt_pk_bf16(a1[2] * sigm(g1[2]), a1[3] * sigm(g1[3]));
                    *(u32x4*)(u + (size_t)(row0 + ai * HALF + m * 16) * DC + 128 * pn + 32 * wc + 8 * fq) = w; }
        } else if (pn < 8) {
            const bool isq = pn < 6; const int hh = 4 * (pn & 1) + wc; const float* gg = isq ? qg : kg; bf16* dst = (isq ? q : k) + hh * 64 + 8 * fq; const float sc0 = isq ? 0.125f * 1.44269504089f : 1.f;
            f32x4 gv[2][2];
#pragma unroll
            for (int bj = 0; bj < 2; ++bj)
#pragma unroll
                for (int n = 0; n < 2; ++n) gv[bj][n] = *(const f32x4*)(gg + 32 * bj + 8 * fq + 4 * n);
#pragma unroll
            for (int ai = 0; ai < 2; ++ai)
#pragma unroll
                for (int m = 0; m < 4; ++m) { float ss = 0.f;
#pragma unroll
                    for (int bj = 0; bj < 2; ++bj)
#pragma unroll
                        for (int n = 0; n < 2; ++n) { const f32x4 v = acc[ai][bj][m][n]; ss += (v[0] * v[0] + v[1] * v[1]) + (v[2] * v[2] + v[3] * v[3]); }
                    ss += __shfl_xor(ss, 16); ss += __shfl_xor(ss, 32);
                    const float rs = rsqrtf(ss * (1.f / 64.f) + EPS) * sc0;
#pragma unroll
                    for (int bj = 0; bj < 2; ++bj) { const f32x4 v0 = acc[ai][bj][m][0] * gv[bj][0] * rs, v1 = acc[ai][bj][m][1] * gv[bj][1] * rs; u32x4 w;
                        w.x = cvt_pk_bf16(v0[0], v0[1]); w.y = cvt_pk_bf16(v0[2], v0[3]); w.z = cvt_pk_bf16(v1[0], v1[1]); w.w = cvt_pk_bf16(v1[2], v1[3]);
                        *(u32x4*)(dst + (size_t)(row0 + ai * HALF + m * 16) * 512 + 32 * bj) = w; } }
        } else if (pn < 10) {
            const int vc0 = 256 * (pn - 8) + 32 * wc + 8 * fq;
#pragma unroll
            for (int ai = 0; ai < 2; ++ai)
#pragma unroll
                for (int m = 0; m < 4; ++m)
#pragma unroll
                    for (int bj = 0; bj < 2; ++bj)
#pragma unroll
                        for (int n = 0; n < 2; ++n)
#pragma unroll
                            for (int i = 0; i < 4; ++i) vT[(size_t)(vc0 + 128 * bj + 4 * n + i) * S + row0 + ai * HALF + m * 16] = (bf16)f2bf(acc[ai][bj][m][n][i]);
        } else {
            bf16* dst = (pn < 14 ? sga : sgb) + 256 * ((pn - 10) & 3) + 32 * wc + 8 * fq;
#pragma unroll
            for (int ai = 0; ai < 2; ++ai)
#pragma unroll
                for (int m = 0; m < 4; ++m)
#pragma unroll
                    for (int bj = 0; bj < 2; ++bj) { const f32x4 v0 = acc[ai][bj][m][0], v1 = acc[ai][bj][m][1]; u32x4 w;
                        w.x = cvt_pk_bf16(sigm(v0[0]), sigm(v0[1])); w.y = cvt_pk_bf16(sigm(v0[2]), sigm(v0[3])); w.z = cvt_pk_bf16(sigm(v1[0]), sigm(v1[1])); w.w = cvt_pk_bf16(sigm(v1[2]), sigm(v1[3]));
                        *(u32x4*)(dst + (size_t)(row0 + ai * HALF + m * 16) * D + 128 * bj) = w; }
        }
    }
};
struct EpiMerge {
    static constexpr bool HAS_MID = true; static constexpr int MIN_STORES = 0;
    const bf16* __restrict__ sga; const bf16* __restrict__ sgb; bf16* __restrict__ mrg;
    static __device__ __forceinline__ float lo(unsigned w) { return __uint_as_float(w << 16); }
    static __device__ __forceinline__ float hi(unsigned w) { return __uint_as_float(w & 0xffff0000u); }
    __device__ __forceinline__ void mid(Acc& acc, const Unit& un, int wr, int wc, int fr, int fq) const {
        const size_t o0 = (size_t)(un.pm * BM + wr * 64 + fr) * D + un.pn * BM + 32 * wc + 8 * fq;
#pragma unroll
        for (int ai = 0; ai < 2; ++ai)
#pragma unroll
            for (int m = 0; m < 4; ++m)
#pragma unroll
                for (int bj = 0; bj < 2; ++bj) { const size_t off = o0 + (size_t)(ai * HALF + m * 16) * D + 128 * bj; const u32x4 a = __builtin_nontemporal_load((const u32x4*)(sga + off)), b = *(const u32x4*)(sgb + off);
                    f32x4& v0 = acc[ai][bj][m][0]; f32x4& v1 = acc[ai][bj][m][1];
                    v0[0] *= lo(a.x) * __builtin_amdgcn_rcpf(fmaxf(lo(b.x), 1e-6f)); v0[1] *= hi(a.x) * __builtin_amdgcn_rcpf(fmaxf(hi(b.x), 1e-6f));
                    v0[2] *= lo(a.y) * __builtin_amdgcn_rcpf(fmaxf(lo(b.y), 1e-6f)); v0[3] *= hi(a.y) * __builtin_amdgcn_rcpf(fmaxf(hi(b.y), 1e-6f));
                    v1[0] *= lo(a.z) * __builtin_amdgcn_rcpf(fmaxf(lo(b.z), 1e-6f)); v1[1] *= hi(a.z) * __builtin_amdgcn_rcpf(fmaxf(hi(b.z), 1e-6f));
                    v1[2] *= lo(a.w) * __builtin_amdgcn_rcpf(fmaxf(lo(b.w), 1e-6f)); v1[3] *= hi(a.w) * __builtin_amdgcn_rcpf(fmaxf(hi(b.w), 1e-6f));
                    asm volatile("" ::: "memory"); }
    }
    __device__ __forceinline__ void operator()(const Acc& acc, const Unit& un, int wr, int wc, int fr, int fq) const {
        const size_t o0 = (size_t)(un.pm * BM + wr * 64 + fr) * D + un.pn * BM + 32 * wc + 8 * fq;
#pragma unroll
        for (int ai = 0; ai < 2; ++ai)
#pragma unroll
            for (int m = 0; m < 4; ++m) { u32x4 b[2];
#pragma unroll
                for (int bj = 0; bj < 2; ++bj) b[bj] = *(const u32x4*)(sgb + o0 + (size_t)(ai * HALF + m * 16) * D + 128 * bj);
#pragma unroll
                for (int bj = 0; bj < 2; ++bj) { const f32x4 v0 = acc[ai][bj][m][0], v1 = acc[ai][bj][m][1]; const u32x4 bb = b[bj]; u32x4 w;
                    w.x = cvt_pk_bf16(v0[0] * fmaxf(lo(bb.x), 1e-6f), v0[1] * fmaxf(hi(bb.x), 1e-6f)); w.y = cvt_pk_bf16(v0[2] * fmaxf(lo(bb.y), 1e-6f), v0[3] * fmaxf(hi(bb.y), 1e-6f));
                    w.z = cvt_pk_bf16(v1[0] * fmaxf(lo(bb.z), 1e-6f), v1[1] * fmaxf(hi(bb.z), 1e-6f)); w.w = cvt_pk_bf16(v1[2] * fmaxf(lo(bb.w), 1e-6f), v1[3] * fmaxf(hi(bb.w), 1e-6f));
                    *(u32x4*)(mrg + o0 + (size_t)(ai * HALF + m * 16) * D + 128 * bj) = w; } }
    }
};

template <int MU, bool ROWS> struct MoeOrder {
    int nu; unsigned lda2; const char* Bt; unsigned estride, tstride;
    LAS int* ddesc; LAS int* drow; LAS float* dscale;
    static_assert(512 + MU * 1024 * (ROWS ? 2 : 1) <= LDS_CTL_OFF - AUX_OFF, "aux LDS");
    __device__ __forceinline__ void init(int G, int c, const int* ctl, int NP, int pn0, int NPS, const int* stok, const float* rowscale, bool shared_one, float rsc, unsigned lda2_, const void* Bt_, unsigned brow, int rows_e, LAS unsigned char* aux, int WID) {
        const int R = G >> 3, x = c & 7, r = c >> 3;
        const int tid0 = otid(WID); int ent = 0; if (tid0 < MU) { const int k0 = r + R * tid0; ent = ldc(ctl + C_XL + x * MAXT + (k0 / NP < MAXT ? k0 / NP : MAXT - 1)); }
        const int xn = ldc(ctl + C_XN + x);
        lda2 = lda2_; Bt = (const char*)Bt_; estride = (unsigned)rows_e * brow; tstride = (unsigned)BM * brow;
        ddesc = (LAS int*)aux; drow = (LAS int*)(aux + 512); dscale = (LAS float*)(aux + 512 + (ROWS ? MU * 1024 : 0));
        const int tid = tid0; const int total = xn * NP + 8 * NPS;
        nu = 0; if (r < R) for (int k = r; k < total && nu < MU; k += R) ++nu;
        if (tid < MU) { int k = r + R * tid, pm = 0, pn = 0, e = NE, ok = 0;
            if (tid < nu) { ok = 1;
                if (k < xn * NP) { pm = ent & 0xffff; pn = pn0 + k % NP; e = ent >> 16; }
                else { k -= xn * NP; pm = MAXT + x * 8 + k / NPS; pn = pn0 + k % NPS; e = NE; } }
            ddesc[4 * tid + 0] = pm; ddesc[4 * tid + 1] = pn; ddesc[4 * tid + 2] = e; ddesc[4 * tid + 3] = ok; }
        __syncthreads();
        for (int j = 0; j < nu; ++j) { const int pm = ddesc[4 * j], e = ddesc[4 * j + 2];
            for (int rr = tid; rr < BM; rr += NTHR) { const int row = pm * BM + rr;
                if (ROWS) { int tok = row - MAXSLOT; if (e < NE) { tok = stok[row]; tok = tok < 0 ? 0 : tok; } drow[j * BM + rr] = tok; }
                dscale[j * BM + rr] = ((shared_one && e >= NE) ? 1.f : rowscale[row]) * rsc; } }
        __syncthreads();
    }
    __device__ __forceinline__ bool next(int i, Unit& u) const {
        if (i >= nu) return false;
        u.pm = __builtin_amdgcn_readfirstlane(ddesc[4 * i]); u.pn = __builtin_amdgcn_readfirstlane(ddesc[4 * i + 1]); u.e = __builtin_amdgcn_readfirstlane(ddesc[4 * i + 2]); u.slot = i; return true;
    }
    __device__ __forceinline__ unsigned a_off(const Unit& u, int r_) const { return (unsigned)(ROWS ? drow[u.slot * BM + r_] : u.pm * BM + r_) * lda2; }
    __device__ __forceinline__ unsigned a_koff(const Unit&) const { return 0u; }
    __device__ __forceinline__ const char* b_ptr(const Unit& u) const { return Bt + (size_t)((unsigned)u.e * estride + (unsigned)u.pn * tstride); }
};
typedef MoeOrder<13, true> MoeGU; typedef MoeOrder<26, false> MoeDN;
struct EpiGateUp {
    static constexpr bool HAS_MID = false; static constexpr int MIN_STORES = 8;
    unsigned char* __restrict__ hmid; const LAS float* srs;
    __device__ __forceinline__ void mid(Acc&, const Unit&, int, int, int, int) const {}
    __device__ __forceinline__ void operator()(const Acc& acc, const Unit& un, int wr, int wc, int fr, int fq) const {
        const int r0 = un.pm * BM + wr * 64 + fr;
        unsigned char* dst = hmid + (size_t)r0 * DE + 128 * un.pn + 32 * wc + 8 * fq;
#pragma unroll
        for (int ai = 0; ai < 2; ++ai) { float rs[4];
#pragma unroll
            for (int m = 0; m < 4; ++m) rs[m] = srs[un.slot * BM + wr * 64 + fr + ai * HALF + m * 16];
#pragma unroll
            for (int m = 0; m < 4; ++m) { const f32x4 g0 = acc[ai][0][m][0] * rs[m], g1 = acc[ai][0][m][1] * rs[m], u0 = acc[ai][1][m][0] * rs[m], u1 = acc[ai][1][m][1] * rs[m]; u32x2 w;
                w.x = pk4f8c(g0[0] * sigm(g0[0]) * u0[0], g0[1] * sigm(g0[1]) * u0[1], g0[2] * sigm(g0[2]) * u0[2], g0[3] * sigm(g0[3]) * u0[3]);
                w.y = pk4f8c(g1[0] * sigm(g1[0]) * u1[0], g1[1] * sigm(g1[1]) * u1[1], g1[2] * sigm(g1[2]) * u1[2], g1[3] * sigm(g1[3]) * u1[3]);
                *(u32x2*)(dst + (size_t)(ai * HALF + m * 16) * DE) = w; } }
    }
};
struct EpiDown {
    static constexpr bool HAS_MID = false; static constexpr int MIN_STORES = 16;
    unsigned char* __restrict__ y; const LAS float* sw; unsigned char* __restrict__ ysh;
    __device__ __forceinline__ void mid(Acc&, const Unit&, int, int, int, int) const {}
    __device__ __forceinline__ void operator()(const Acc& acc, const Unit& un, int wr, int wc, int fr, int fq) const {
        const int r0 = un.pm * BM + wr * 64 + fr;
        unsigned char* dst = (un.e < NE ? y + (size_t)r0 * D : ysh + (size_t)(r0 - MAXSLOT) * D) + un.pn * BM + 64 * wc + 16 * fq;
#pragma unroll
        for (int ai = 0; ai < 2; ++ai) { float wt[4];
#pragma unroll
            for (int m = 0; m < 4; ++m) wt[m] = sw[un.slot * BM + wr * 64 + fr + ai * HALF + m * 16];
#pragma unroll
            for (int m = 0; m < 4; ++m) { u32x4 w;
#pragma unroll
                for (int bj = 0; bj < 2; ++bj)
#pragma unroll
                    for (int n = 0; n < 2; ++n) { const f32x4 t = acc[ai][bj][m][n] * wt[m]; w[2 * bj + n] = pk4f8c(t[0], t[1], t[2], t[3]); }
                *(u32x4*)(dst + (size_t)(ai * HALF + m * 16) * D) = w; }
        }
    }
};
}

constexpr int N_ECVT = 3 * (NE + 1) * (D / 64) * (DE / 64);
struct CvtDesc { const float* W; unsigned char* WT; const float* gk; int N, ldo, mode, k0, n0; float wsc; };
__device__ __forceinline__ void cvt_desc(const Params& p, int it, CvtDesc& d) {
    constexpr int I_E = (D / 64) * (DE / 64);
    const int kind = it / ((NE + 1) * I_E), rr = it % ((NE + 1) * I_E), e = rr / I_E, item = rr % I_E;
    if (kind < 2) { d.W = (kind == 0 ? (e < NE ? p.w_eg + (size_t)e * D * DE : p.w_sg) : (e < NE ? p.w_eu + (size_t)e * D * DE : p.w_su)); d.WT = p.ws + WS_WGU + (size_t)e * 512 * D; d.gk = p.norm_ffn_g;
        d.N = DE; d.ldo = D; d.mode = 1 + kind; d.wsc = WGU_SC; }
    else { d.W = e < NE ? p.w_ed + (size_t)e * DE * D : p.w_sd; d.WT = p.ws + WS_WD + (size_t)e * D * DE; d.gk = nullptr; d.N = D; d.ldo = DE; d.mode = 0; d.wsc = WD_SC; }
    const int nblk = d.N / 64; d.k0 = 64 * (item / nblk); d.n0 = 64 * (item % nblk);
}
__device__ __forceinline__ void cvt_load(const CvtDesc& d, f32x4 (&v)[16], int lane) {
    const int kr = lane >> 4, n4 = (lane & 15) * 4;
#pragma unroll
    for (int i = 0; i < 16; ++i) { const int kk = 4 * (kr + 4 * (i >> 2)) + (i & 3); v[i] = __builtin_nontemporal_load((const f32x4*)(d.W + (size_t)(d.k0 + kk) * d.N + d.n0 + n4)); }
}
__device__ __forceinline__ void cvt_finish(const CvtDesc& d, f32x4 (&v)[16], float* scr, int lane) {
    const int kr = lane >> 4, n4 = (lane & 15) * 4; unsigned* tl = (unsigned*)scr;
#pragma unroll
    for (int q = 0; q < 4; ++q) { const int kq = kr + 4 * q; f32x4 x0 = v[4 * q], x1 = v[4 * q + 1], x2 = v[4 * q + 2], x3 = v[4 * q + 3];
        float s0 = d.wsc, s1 = d.wsc, s2 = d.wsc, s3 = d.wsc;
        if (d.gk) { const f32x4 gv = *(const f32x4*)(d.gk + d.k0 + 4 * kq); s0 *= gv[0]; s1 *= gv[1]; s2 *= gv[2]; s3 *= gv[3]; }
        x0 = x0 * s0; x1 = x1 * s1; x2 = x2 * s2; x3 = x3 * s3;
        u32x4 w; w.x = pk4f8(x0[0], x1[0], x2[0], x3[0]); w.y = pk4f8(x0[1], x1[1], x2[1], x3[1]); w.z = pk4f8(x0[2], x1[2], x2[2], x3[2]); w.w = pk4f8(x0[3], x1[3], x2[3], x3[3]);
        *(u32x4*)(tl + kq * 64 + (n4 ^ (16 * q))) = w; }
    asm volatile("s_waitcnt lgkmcnt(0)" ::: "memory");
    const int c = lane & 3;
#pragma unroll
    for (int j = 0; j < 4; ++j) { const int n = (lane >> 2) + 16 * j; const unsigned* sp = tl + (4 * c) * 64 + (n ^ (16 * c));
        u32x4 o; o.x = sp[0]; o.y = sp[64]; o.z = sp[128]; o.w = sp[192];
        const int cn = d.n0 + n; const int row = d.mode == 0 ? MapDown{}(cn) : 256 * (cn >> 7) + 128 * (d.mode - 1) + (cn & 127);
        __builtin_nontemporal_store(o, (u32x4*)(d.WT + (size_t)row * d.ldo + d.k0 + 16 * c)); }
    asm volatile("s_waitcnt lgkmcnt(0)" ::: "memory");
}
__device__ __forceinline__ void expert_cvt_loop(const Params& p, int gw, int NGW, float* scr, int lane) {
    CvtDesc da, db; f32x4 va[16], vb[16];
    int it = gw; if (it >= N_ECVT) return;
    cvt_desc(p, it, da); cvt_load(da, va, lane);
    for (;;) {
        int itn = it + NGW; const bool hb = itn < N_ECVT;
        if (hb) { cvt_desc(p, itn, db); cvt_load(db, vb, lane); }
        cvt_finish(da, va, scr, lane);
        if (!hb) break;
        it = itn; itn = it + NGW; const bool ha = itn < N_ECVT;
        if (ha) { cvt_desc(p, itn, da); cvt_load(da, va, lane); }
        cvt_finish(db, vb, scr, lane);
        if (!ha) break;
        it = itn;
    }
}

#define PHASE_VARS const int tid = otid(WID), lane = tid & 63, wave = owid(WID), gw = blockIdx.x * NWAVES + wave; float* wscr = (float*)(lds + wave * WSCR_BYTES); (void)lane; (void)gw; (void)wscr;
typedef const __attribute__((address_space(4))) Params* KParams;
__device__ __forceinline__ Params load_params() {
#if defined(__HIP_DEVICE_COMPILE__)
    KParams q = (KParams)__builtin_amdgcn_kernarg_segment_ptr(); asm volatile("" : "+s"(q)); Params r; __builtin_memcpy(&r, (const __attribute__((address_space(4))) void*)q, sizeof(Params)); return r;
#else
    return Params{};
#endif
}
#define PHASE_P const Params p = load_params(); unsigned char* ws = p.ws; int* ctl = (int*)(ws + WS_CTL); (void)ctl;
__global__ void __launch_bounds__(NTHR, 2) mk_fwd(Params p_arg) {
    extern __shared__ __attribute__((aligned(16))) unsigned char lds[];
    const int G = gridDim.x, NGW = G * NWAVES;
    const int WID = __builtin_amdgcn_readfirstlane(threadIdx.x >> 6);
    for (int u = otid(WID); u < (LDS_BYTES - LDS_CTL_OFF) / 4; u += NTHR) ((unsigned*)(lds + LDS_CTL_OFF))[u] = 0u;
    __syncthreads();
    XcdBarrier bar = xcd_barrier_post((unsigned*)(p_arg.ws + WS_CTL) + CW_BAR, (volatile LAS unsigned*)(lds + LDS_CTL_OFF), otid(WID) == 0);
#define xcd_barrier(b) xcd_barrier_(b, otid(WID) == 0)

    {
        PHASE_P
        PHASE_VARS
        constexpr int I_IN = (D / 64) * (DIN / 64), I_CO = (512 / 64) * (D / 64), I_O = (D / 64) * (D / 64), I_R = D / 64, I_E = (D / 64) * (DE / 64);
        constexpr int NMIX = I_IN + 2 * I_CO + I_O + 2 * I_R, NIT = NMIX; (void)I_E;
        for (int rep = 0; rep < REPS(10); ++rep)
        for (int it = gw; it < NIT; it += NGW) {
            int r = it;
            if (r < I_IN) { transpose_item<false>(p.w_in, D, DIN, (bf16*)(ws + WS_WIN), D, 0, MapIn{}, nullptr, wscr, r, lane); continue; } r -= I_IN;
            if (r < I_CO) { transpose_item<false>(p.w_conv_out, 512, D, (bf16*)(ws + WS_WCAT), D, 0, MapId{0}, nullptr, wscr, r, lane); continue; } r -= I_CO;
            if (r < I_CO) { transpose_item<false>(p.w_attn_out, 512, D, (bf16*)(ws + WS_WCAT), D, 512, MapId{0}, nullptr, wscr, r, lane); continue; } r -= I_CO;
            if (r < I_O) { transpose_item<false>(p.w_o, D, D, (bf16*)(ws + WS_WO), D, 0, MapId{0}, nullptr, wscr, r, lane); continue; } r -= I_O;
            if (r < I_R) { transpose_item<false>(p.w_router, D, NE, (bf16*)(ws + WS_WRH), D, 0, MapId{0}, p.norm_ffn_g, wscr, r, lane); continue; } r -= I_R;
            transpose_item<true>(p.w_router, D, NE, (bf16*)(ws + WS_WRL), D, 0, MapId{0}, p.norm_ffn_g, wscr, r, lane);
        }
        for (int rep = 0; rep < REPS(11); ++rep)
        for (int m = gw; m < S; m += 4 * NGW) {
            if (m + 3 * NGW < S) {
                f32x4 v[4][4]; float rs[4];
#pragma unroll
                for (int r = 0; r < 4; ++r)
#pragma unroll
                    for (int j = 0; j < 4; ++j) v[r][j] = __builtin_nontemporal_load((const f32x4*)(p.x + (size_t)(m + r * NGW) * D) + lane + 64 * j);
#pragma unroll
                for (int r = 0; r < 4; ++r) { float ss = 0.f;
#pragma unroll
                    for (int j = 0; j < 4; ++j) ss += (v[r][j].x * v[r][j].x + v[r][j].y * v[r][j].y) + (v[r][j].z * v[r][j].z + v[r][j].w * v[r][j].w);
                    rs[r] = rsqrtf(wave_sum(ss) * (1.f / D) + EPS); }
#pragma unroll
                for (int j = 0; j < 4; ++j) { const f32x4 gg = ((const f32x4*)p.norm_mix_g)[lane + 64 * j];
#pragma unroll
                    for (int r = 0; r < 4; ++r) { u32x2 w2; w2.x = pk2(v[r][j].x * rs[r] * gg.x, v[r][j].y * rs[r] * gg.y); w2.y = pk2(v[r][j].z * rs[r] * gg.z, v[r][j].w * rs[r] * gg.w);
                        ((u32x2*)((bf16*)(ws + WS_H) + (size_t)(m + r * NGW) * D))[lane + 64 * j] = w2; } }
            } else for (int mm = m; mm < S; mm += NGW) rmsnorm_row(p.x + (size_t)mm * D, p.norm_mix_g, (bf16*)(ws + WS_H) + (size_t)mm * D, lane);
        }
    }
    xcd_barrier(bar);
    {
        PHASE_P
        const int q8 = (int)(blockIdx.x >> 3), x8 = (int)(blockIdx.x & 7); const bool split = (G == 256), streamer = split && ((q8 & 3) == 3);
        if (!streamer) {
            pg8::DenseOrder So; So.init(S, DIN, D, D, ws + WS_WIN, split ? 192 : G, split ? 8 * (q8 - (q8 >> 2)) + x8 : (int)blockIdx.x);
            pg8::EpiProj E{(bf16*)(ws + WS_U), (bf16*)(ws + WS_Q), (bf16*)(ws + WS_K), (bf16*)(ws + WS_VT), (bf16*)(ws + WS_SGA), (bf16*)(ws + WS_SGB), p.q_norm_g, p.k_norm_g};
            pg8::gemm_phase<pg8::EpiProj, pg8::DenseOrder, true>((LAS unsigned char*)lds, (const char*)(ws + WS_H), D, So, E, WID);
        } else {
            PHASE_VARS
            expert_cvt_loop(p, (8 * (q8 >> 2) + x8) * NWAVES + wave, 64 * NWAVES, wscr, lane);
        }
    }
#if PROBE == 1
    {
        PHASE_P
        pg8::DenseOrder So; So.init(S, DIN, D, D, ws + WS_WIN, G, (int)blockIdx.x);
        pg8::EpiProj E{(bf16*)(ws + WS_U), (bf16*)(ws + WS_Q), (bf16*)(ws + WS_K), (bf16*)(ws + WS_VT), (bf16*)(ws + WS_SGA), (bf16*)(ws + WS_SGB), p.q_norm_g, p.k_norm_g};
        pg8::gemm_phase<pg8::EpiProj, pg8::DenseOrder, true>((LAS unsigned char*)lds, (const char*)(ws + WS_H), D, So, E, WID);
    }
#endif
    xcd_barrier(bar);
    {
        PHASE_P
        PHASE_VARS
        const bool docvt = (G != 256), cvt_first = docvt && (((blockIdx.x >> 3) & 1) != 0);
        if (cvt_first) { for (int rep = 0; rep < REPS(22); ++rep) expert_cvt_loop(p, gw, NGW, wscr, lane); __syncthreads(); }
        conv_phase(p, lds, G, WID);
        for (int rep = 0; rep < REPS(21); ++rep) attn_phase(p, lds, G, WID);
        if (docvt && !cvt_first) { __syncthreads(); for (int rep = 0; rep < REPS(22); ++rep) expert_cvt_loop(p, gw, NGW, wscr, lane); }
    }
    xcd_barrier(bar);
    {
        PHASE_P
        pg8::DenseOrder So; So.init(S, D, D, D, ws + WS_WCAT, G, (int)blockIdx.x);
        pg8::EpiMerge E{(const bf16*)(ws + WS_SGA), (const bf16*)(ws + WS_SGB), (bf16*)(ws + WS_MRG)};
        pg8::gemm_phase<pg8::EpiMerge, pg8::DenseOrder, true>((LAS unsigned char*)lds, (const char*)(ws + WS_U2), D, So, E, WID);
    }
#if PROBE == 3
    {
        PHASE_P
        pg8::DenseOrder So; So.init(S, D, D, D, ws + WS_WCAT, G, (int)blockIdx.x);
        pg8::EpiMerge E{(const bf16*)(ws + WS_SGA), (const bf16*)(ws + WS_SGB), (bf16*)(ws + WS_MRG)};
        pg8::gemm_phase<pg8::EpiMerge, pg8::DenseOrder, true>((LAS unsigned char*)lds, (const char*)(ws + WS_U2), D, So, E, WID);
    }
#endif
    xcd_barrier(bar);
    {
        PHASE_P
        pg8::DenseOrder So; So.init(S, D, D, D, ws + WS_WO, G, (int)blockIdx.x);
        pg8::EpiResid E{p.x, p.out, ws + WS_H};
        pg8::gemm_phase<pg8::EpiResid, pg8::DenseOrder, true>((LAS unsigned char*)lds, (const char*)(ws + WS_MRG), D, So, E, WID);
    }
#if PROBE == 4
    {
        PHASE_P
        pg8::DenseOrder So; So.init(S, D, D, D, ws + WS_WO, G, (int)blockIdx.x);
        pg8::EpiResid E{p.x, p.out, ws + WS_H};
        pg8::gemm_phase<pg8::EpiResid, pg8::DenseOrder, true>((LAS unsigned char*)lds, (const char*)(ws + WS_MRG), D, So, E, WID);
    }
#endif
    xcd_barrier(bar);
    {
        PHASE_P
        PHASE_VARS
        constexpr int RST = 528, PART = 64 * RST, BUF = 2 * PART;
        const bf16* wrh = (const bf16*)(ws + WS_WRH); const bf16* wrl = (const bf16*)(ws + WS_WRL); float* srs = (float*)(ws + WS_SRS);
        int* hist = (int*)(lds + LDS_CTL_OFF + 256); float* lgs = (float*)lds;
        const int g = lane >> 4, li = lane & 15, tt = wave >> 1, nh = wave & 1;
        for (int rep = 0; rep < REPS(50); ++rep)
        for (int blk = blockIdx.x; blk < S / 64; blk += G) {
            if (tid < NE) hist[tid] = 0;
            u32x4 st[8];
            const unsigned goff = (unsigned)(((tid >> 5) * D + (tid & 31) * 8) * 2), loff = (unsigned)((tid >> 5) * RST + (tid & 31) * 16);
#define R_LOAD(c) do { _Pragma("unroll") for (int j = 0; j < 8; ++j) { const char* ub = (const char*)((j >> 2) ? wrl : wrh) + (size_t)(16 * (j & 3)) * D * 2 + (c) * 512; \
                st[j] = *(const u32x4*)(ub + goff); } } while (0)
#define R_WRITE(b) do { _Pragma("unroll") for (int j = 0; j < 8; ++j) *(u32x4*)(lds + (b) * BUF + (j >> 2) * PART + 16 * (j & 3) * RST + loff) = st[j]; } while (0)
            const float* xr = p.out + (size_t)(blk * 64 + tt * 16 + li) * D + 8 * g;
            f32x4 acc[2]; float ssq = 0.f;
            for (int rep2 = 0; rep2 < REPS(51); ++rep2) {
            R_LOAD(0); R_WRITE(0); __syncthreads();
            ssq = 0.f; acc[0] = (f32x4){0.f, 0.f, 0.f, 0.f}; acc[1] = acc[0];
            f32x4 xv[8][2];
#pragma unroll
            for (int s8 = 0; s8 < 8; ++s8) { xv[s8][0] = *(const f32x4*)(xr + 32 * s8); xv[s8][1] = *(const f32x4*)(xr + 32 * s8 + 4); }
#pragma unroll 1
            for (int c = 0; c < 4; ++c) {
                if (c < 3) R_LOAD(c + 1);
                const unsigned char* bb = lds + (c & 1) * BUF + (32 * nh + li) * RST + 16 * g;
#pragma unroll
                for (int hf = 0; hf < 2; ++hf) {
#pragma unroll
                    for (int s4 = 0; s4 < 4; ++s4) { const int s8 = 4 * hf + s4;
                        const f32x4 x0 = xv[s8][0], x1 = xv[s8][1];
                        ssq += (x0[0] * x0[0] + x0[1] * x0[1]) + (x0[2] * x0[2] + x0[3] * x0[3]) + (x1[0] * x1[0] + x1[1] * x1[1]) + (x1[2] * x1[2] + x1[3] * x1[3]);
                        union { bf16x8 v; unsigned w[4]; } ah, al;
                        ah.w[0] = pk2(x0[0], x0[1]); ah.w[1] = pk2(x0[2], x0[3]); ah.w[2] = pk2(x1[0], x1[1]); ah.w[3] = pk2(x1[2], x1[3]);
                        al.w[0] = pk2(x0[0] - bf2f(ah.w[0] & 0xffff), x0[1] - bf2f(ah.w[0] >> 16)); al.w[1] = pk2(x0[2] - bf2f(ah.w[1] & 0xffff), x0[3] - bf2f(ah.w[1] >> 16));
                        al.w[2] = pk2(x1[0] - bf2f(ah.w[2] & 0xffff), x1[1] - bf2f(ah.w[2] >> 16)); al.w[3] = pk2(x1[2] - bf2f(ah.w[3] & 0xffff), x1[3] - bf2f(ah.w[3] >> 16));
#pragma unroll
                        for (int n2 = 0; n2 < 2; ++n2) { const bf16x8 wh = *(const bf16x8*)(bb + n2 * 16 * RST + 64 * s8), wl = *(const bf16x8*)(bb + PART + n2 * 16 * RST + 64 * s8);
                            acc[n2] = __builtin_amdgcn_mfma_f32_16x16x32_bf16(wh, ah.v, acc[n2], 0, 0, 0);
                            acc[n2] = __builtin_amdgcn_mfma_f32_16x16x32_bf16(wh, al.v, acc[n2], 0, 0, 0);
                            acc[n2] = __builtin_amdgcn_mfma_f32_16x16x32_bf16(wl, ah.v, acc[n2], 0, 0, 0); } }
                    if (c < 3) {
#pragma unroll
                        for (int s4 = 0; s4 < 4; ++s4) { const int s8 = 4 * hf + s4; xv[s8][0] = *(const f32x4*)(xr + (c + 1) * 256 + 32 * s8); xv[s8][1] = *(const f32x4*)(xr + (c + 1) * 256 + 32 * s8 + 4); } }
                }
                if (c < 3) R_WRITE((c + 1) & 1);
                __syncthreads();
            }
            }
#undef R_LOAD
#undef R_WRITE
            ssq += __shfl_xor(ssq, 16); ssq += __shfl_xor(ssq, 32);
            const float rs = rsqrtf(ssq * (1.f / D) + EPS);
            if (g == 0 && nh == 0) srs[MAXSLOT + blk * 64 + tt * 16 + li] = rs;
#pragma unroll
            for (int n2 = 0; n2 < 2; ++n2)
#pragma unroll
                for (int r = 0; r < 4; ++r) lgs[(tt * 16 + li) * 65 + 32 * nh + 16 * n2 + 4 * g + r] = acc[n2][r] * rs;
            __syncthreads();
            for (int rep3 = 0; rep3 < REPS(52); ++rep3)
            {   int* hh = hist + (rep3 ? 64 : 0);
                float* gsh = (float*)(lds + 49152); float* wsel = (float*)(lds + 32768);
                const int tok = tid >> 3, j = tid & 7, t = blk * 64 + tok;
                float sc[8], b[8];
#pragma unroll
                for (int i = 0; i < 8; ++i) { sc[i] = sigmoidf_(lgs[tok * 65 + 8 * j + i]); b[i] = sc[i] + p.router_bias[8 * j + i]; }
                { float m1 = -3.0e38f, m2 = -3.0e38f;
#pragma unroll
                  for (int i = 0; i < 8; ++i) { const float v = b[i]; if (v > m1) { m2 = m1; m1 = v; } else if (v > m2) m2 = v; }
                  gsh[tok * 8 + j] = m1 + m2; }
                asm volatile("s_waitcnt lgkmcnt(0)" ::: "memory");
                bool mine;
                { const f32x4 ga = *(const f32x4*)(gsh + tok * 8), gb = *(const f32x4*)(gsh + tok * 8 + 4);
                  const float gq[8] = {ga[0], ga[1], ga[2], ga[3], gb[0], gb[1], gb[2], gb[3]}; const float gme = (j == 0 ? gq[0] : j == 1 ? gq[1] : j == 2 ? gq[2] : j == 3 ? gq[3] : j == 4 ? gq[4] : j == 5 ? gq[5] : j == 6 ? gq[6] : gq[7]);
                  int r = 0;
#pragma unroll
                  for (int q = 0; q < 8; ++q) r += (gq[q] > gme || (gq[q] == gme && q < j)) ? 1 : 0;
                  mine = r < TOPG; }
                unsigned taken = mine ? 0u : 0xffu; float wpart = 0.f;
                int* tidx = (int*)(ws + WS_TIDX) + t * 8;
#define DPPF(x, ctrl) __uint_as_float((unsigned)__builtin_amdgcn_update_dpp(0, (int)__float_as_uint(x), ctrl, 0xf, 0xf, true))
#define DPPI(x, ctrl) __builtin_amdgcn_update_dpp(0, x, ctrl, 0xf, 0xf, true)
#pragma unroll 1
                for (int kq = 0; kq < TOPK; ++kq) {
                    float bv = -3.0e38f, bs = 0.f; int bi = 64;
#pragma unroll
                    for (int i = 0; i < 8; ++i) { const bool ok = !((taken >> i) & 1u) && b[i] > bv; bv = ok ? b[i] : bv; bs = ok ? sc[i] : bs; bi = ok ? 8 * j + i : bi; }
                    float mv = bv; int mi = bi;
#pragma unroll
                    for (int st = 0; st < 3; ++st) { const int ctrl = st == 0 ? 0xB1 : (st == 1 ? 0x4E : 0x141);
                        const float ov = st == 0 ? DPPF(mv, 0xB1) : (st == 1 ? DPPF(mv, 0x4E) : DPPF(mv, 0x141)); const int oi = st == 0 ? DPPI(mi, 0xB1) : (st == 1 ? DPPI(mi, 0x4E) : DPPI(mi, 0x141)); (void)ctrl;
                        const bool tk = ov > mv || (ov == mv && oi < mi); mv = tk ? ov : mv; mi = tk ? oi : mi; }
                    if (mi == bi && bi < 64) { taken |= 1u << (bi & 7); wpart += bs; tidx[kq] = bi; wsel[tok * 8 + kq] = bs; atomicAdd(hh + bi, 1); }
                }
#undef DPPF
#undef DPPI
                float wsum = wpart; wsum += __shfl_xor(wsum, 1); wsum += __shfl_xor(wsum, 2); wsum += __shfl_xor(wsum, 4);
                asm volatile("s_waitcnt lgkmcnt(0)" ::: "memory");
                ((float*)(ws + WS_TW))[t * 8 + j] = wsel[tok * 8 + j] * (ROUTE_SCALE / wsum);
            }
            __syncthreads();
            if (tid < NE) ((int*)(ws + WS_CNTB))[blk * NE + tid] = hist[tid];
            __syncthreads();
        }
    }
    xcd_barrier(bar);
    {
        PHASE_P
        PHASE_VARS
        int* s_part = (int*)lds; int* s_pre = s_part + 512; int* s_tot = s_pre + 512; int* s_base = s_tot + 64; int* s_pad = s_base + 64; int* s_start = s_pad + 64; int* s_cur = s_start + 80;
        const int* cntb = (const int*)(ws + WS_CNTB);
        int* stok = (int*)(ws + WS_STOK); float* sw = (float*)(ws + WS_SW); int* tslot = (int*)(ws + WS_TSLOT); float* srs = (float*)(ws + WS_SRS);
        const int* tidx = (const int*)(ws + WS_TIDX); const float* tw = (const float*)(ws + WS_TW);
        for (int rep = 0; rep < REPS(60); ++rep)
        for (int blk = blockIdx.x; blk < S / 64; blk += G) {
            { const int e = tid & 63, part = tid >> 6; int a = 0, b = 0;
              for (int w = 32 * part; w < 32 * part + 32; ++w) { const int v = cntb[w * NE + e]; a += v; b += (w < blk) ? v : 0; }
              s_part[tid] = a; s_pre[tid] = b; }
            __syncthreads();
            if (tid < NE) { int a = 0, b = 0;
#pragma unroll
                for (int q = 0; q < 8; ++q) { a += s_part[q * 64 + tid]; b += s_pre[q * 64 + tid]; }
                s_tot[tid] = a; s_base[tid] = b; s_pad[tid] = (a + 255) >> 8; s_cur[tid] = 0; }
            __syncthreads();
            if (tid < NE) {
                const int v = s_pad[tid]; int inc = v;
#pragma unroll
                for (int o = 1; o < 64; o <<= 1) { const int t = __shfl_up(inc, o); if (lane >= o) inc += t; }
                s_start[tid] = (inc - v) * 256; if (tid == NE - 1) s_start[NE] = inc * 256; }
            __syncthreads();
            if (blk == 0) {
                if (tid < NE) { const int st = s_start[tid] >> 8; for (int j = 0; j < s_pad[tid]; ++j) ctl[C_TEXP + st + j] = tid; }
                if (tid == 0) ctl[C_NT] = s_start[NE] >> 8;
                int* eg = s_cur + 64;
                if (tid < NE) { int rank = 0; for (int e = 0; e < NE; ++e) rank += (s_pad[e] > s_pad[tid] || (s_pad[e] == s_pad[tid] && e < tid)) ? 1 : 0; eg[tid] = ((rank >> 3) & 1) ? 7 - (rank & 7) : (rank & 7); }
                __syncthreads();
                if (tid < NE) { const int x = eg[tid]; int off = 0, tot = 0;
                    for (int e = 0; e < NE; ++e) { const int pe = (eg[e] == x) ? s_pad[e] : 0; tot += pe; off += (e < tid) ? pe : 0; }
                    const int st = s_start[tid] >> 8; for (int j = 0; j < s_pad[tid]; ++j) ctl[C_XL + x * MAXT + off + j] = (st + j) | (tid << 16);
                    ctl[C_XN + x] = tot; }
            }
            if (blk < NE) { const int e = blk; const int lo = s_start[e] + s_tot[e], hi = s_start[e + 1]; for (int sl = lo + tid; sl < hi; sl += NTHR) { stok[sl] = -1; sw[sl] = 0.f; srs[sl] = 0.f; } }
            { const int i = blk * 512 + tid; const int e = tidx[i]; const int pos = atomicAdd(s_cur + e, 1); const int slot = s_start[e] + s_base[e] + pos;
              stok[slot] = i >> 3; sw[slot] = tw[i]; tslot[i] = slot; srs[slot] = srs[MAXSLOT + (i >> 3)]; }
            __syncthreads();
        }
    }
    xcd_barrier(bar);
    {
        PHASE_P
        pg8::MoeGU So; So.init(G, (int)blockIdx.x, ctl, 2, 0, 2, (const int*)(ws + WS_STOK), (const float*)(ws + WS_SRS), false, 1.f / WGU_SC, (unsigned)D, ws + WS_WGU, (unsigned)D, 512, (LAS unsigned char*)lds + AUX_OFF, WID);
        pg8::EpiGateUp E{ws + WS_HMID, So.dscale};
        pg8::gemm_phase<pg8::EpiGateUp, pg8::MoeGU, true, 0>((LAS unsigned char*)lds, (const char*)(ws + WS_H), D / 2, So, E, WID);
    }
#if PROBE == 7
    {
        PHASE_P
        pg8::MoeGU So; So.init(G, (int)blockIdx.x, ctl, 2, 0, 2, (const int*)(ws + WS_STOK), (const float*)(ws + WS_SRS), false, 1.f / WGU_SC, (unsigned)D, ws + WS_WGU, (unsigned)D, 512, (LAS unsigned char*)lds + AUX_OFF, WID);
        pg8::EpiGateUp E{ws + WS_HMID, So.dscale};
        pg8::gemm_phase<pg8::EpiGateUp, pg8::MoeGU, true, 0>((LAS unsigned char*)lds, (const char*)(ws + WS_H), D / 2, So, E, WID);
    }
#endif
    xcd_barrier(bar);
    {
        PHASE_P
        pg8::MoeDN So; So.init(G, (int)blockIdx.x, ctl, 4, 0, 4, nullptr, (const float*)(ws + WS_SW), true, Y_SC / WD_SC, (unsigned)DE, ws + WS_WD, (unsigned)DE, 1024, (LAS unsigned char*)lds + AUX_OFF, WID);
        pg8::EpiDown E{(unsigned char*)(ws + WS_Y), So.dscale, (unsigned char*)(ws + WS_YSH)};
        int kq = DE / 2; asm volatile("" : "+s"(kq));
        pg8::gemm_phase<pg8::EpiDown, pg8::MoeDN, true, 0>((LAS unsigned char*)lds, (const char*)(ws + WS_HMID), kq, So, E, WID);
    }
#if PROBE == 8
    {
        PHASE_P
        pg8::MoeDN So; So.init(G, (int)blockIdx.x, ctl, 4, 0, 4, nullptr, (const float*)(ws + WS_SW), true, Y_SC / WD_SC, (unsigned)DE, ws + WS_WD, (unsigned)DE, 1024, (LAS unsigned char*)lds + AUX_OFF, WID);
        pg8::EpiDown E{(unsigned char*)(ws + WS_Y), So.dscale, (unsigned char*)(ws + WS_YSH)};
        int kq = DE / 2; asm volatile("" : "+s"(kq));
        pg8::gemm_phase<pg8::EpiDown, pg8::MoeDN, true, 0>((LAS unsigned char*)lds, (const char*)(ws + WS_HMID), kq, So, E, WID);
    }
#endif
    xcd_barrier(bar);
    {
        PHASE_P
        PHASE_VARS
        const int* tslot = (const int*)(ws + WS_TSLOT); const unsigned char* y = (const unsigned char*)(ws + WS_Y); const unsigned char* ysh = (const unsigned char*)(ws + WS_YSH);
        for (int rep = 0; rep < REPS(9); ++rep) {
        const float ys = rep == 0 ? 1.f / Y_SC : 0.f;
        for (int tb = gw; tb < S; tb += 8 * NGW) {
            const int tm = tb + (lane >> 3) * NGW; const int myslot = tm < S ? tslot[tm * 8 + (lane & 7)] : 0;
            u32x4 v[2][TOPK + 1]; f32x4 a[2][4];
#define C_LOAD(i, b) do { const int t_ = tb + (i) * NGW; if (t_ < S) { \
                _Pragma("unroll") for (int kq = 0; kq < TOPK; ++kq) { const int sl = __builtin_amdgcn_readlane(myslot, 8 * (i) + kq); v[b][kq] = __builtin_nontemporal_load((const u32x4*)(y + (size_t)sl * D + 16 * lane)); } \
                v[b][TOPK] = __builtin_nontemporal_load((const u32x4*)(ysh + (size_t)t_ * D + 16 * lane)); \
                _Pragma("unroll") for (int j = 0; j < 4; ++j) a[b][j] = *(const f32x4*)(p.out + (size_t)t_ * D + 16 * lane + 4 * j); } } while (0)
#define C_SUM(i, b) do { const int t_ = tb + (i) * NGW; if (t_ < S) { f32x2_t sm[8]; \
                _Pragma("unroll") for (int j = 0; j < 8; ++j) sm[j] = (f32x2_t){0.f, 0.f}; \
                _Pragma("unroll") for (int kq = 0; kq < TOPK + 1; ++kq) _Pragma("unroll") for (int j = 0; j < 4; ++j) { const unsigned w = v[b][kq][j]; \
                    sm[2 * j] = sm[2 * j] + __builtin_amdgcn_cvt_pk_f32_fp8(w, false); sm[2 * j + 1] = sm[2 * j + 1] + __builtin_amdgcn_cvt_pk_f32_fp8(w, true); } \
                float* o = p.out + (size_t)t_ * D + 16 * lane; \
                _Pragma("unroll") for (int j = 0; j < 4; ++j) { f32x4 r = a[b][j]; r[0] += ys * sm[2 * j][0]; r[1] += ys * sm[2 * j][1]; r[2] += ys * sm[2 * j + 1][0]; r[3] += ys * sm[2 * j + 1][1]; *(f32x4*)(o + 4 * j) = r; } } } while (0)
            C_LOAD(0, 0);
#pragma unroll
            for (int i = 0; i < 8; ++i) { if (i < 7) { if (i & 1) C_LOAD(i + 1, 0); else C_LOAD(i + 1, 1); } if (i & 1) C_SUM(i, 1); else C_SUM(i, 0); }
#undef C_LOAD
#undef C_SUM
        }
        if (PROBE == 9 && rep == 0) { asm volatile("s_waitcnt vmcnt(0)" ::: "memory"); __syncthreads(); }
        }
    }
}

extern "C" void kernel_launch(void* const* d_in, const int* in_sizes, int n_in, void* d_out, int out_size, void* d_ws, size_t ws_size, hipStream_t stream) {
    static int grid = 0;
    if (grid == 0) {
        int dev = 0, cus = 0, per_cu = 0;
        (void)hipGetDevice(&dev); (void)hipDeviceGetAttribute(&cus, hipDeviceAttributeMultiprocessorCount, dev);
        (void)hipFuncSetAttribute((const void*)mk_fwd, hipFuncAttributeMaxDynamicSharedMemorySize, LDS_BYTES);
        (void)hipOccupancyMaxActiveBlocksPerMultiprocessor(&per_cu, (const void*)mk_fwd, NTHR, LDS_BYTES);
        (void)hipGetLastError();
        grid = cus > 0 ? cus : 256;
    }
    Params p{};
    const float** pp = (const float**)&p;
    for (int i = 0; i < 22; ++i) pp[i] = (const float*)d_in[i];
    p.out = (float*)d_out; p.ws = (unsigned char*)d_ws;
    (void)hipMemsetAsync((char*)d_ws + WS_CTL, 0, CTL_BYTES, stream);
    hipLaunchKernelGGL(mk_fwd, dim3(grid), dim3(NTHR), LDS_BYTES, stream, p);
}
```
